# Optimizing an MI355X kernel written in HIP

```python
import jax, jax.numpy as jnp
from jax import lax
import numpy as np

D_MODEL = 1024
BATCH = 8
SEQ = 2048
DEPTH = 1

CHUNK = 64
MEM_LEN = 256
D_MIX = D_MODEL
D_A = D_MIX // 2
A_GROUPS = 4
A_CH = D_A // A_GROUPS
A_BLOCK = 128
D_B = D_MIX - D_A
B_HEADS = 8
B_HEAD_DIM = D_B // B_HEADS
B_LEFT_CHUNKS = 8
B_BAND = (B_LEFT_CHUNKS + 1) * CHUNK
REL_CLIP = 128
X_HEADS = 4
X_HEAD_DIM = D_MODEL // X_HEADS
PEER_HEADS = 8
PEER_KEYS = 128
PEER_EXPERTS = PEER_KEYS * PEER_KEYS
PEER_D_KEY = 256
PEER_HALF = PEER_D_KEY // 2
PEER_TOPK = 16
PEER_TOKEN_BLOCK = 128
N_IN = 2 * D_A + 3 * D_B
DN_ALPHA = (2.0 * DEPTH) ** 0.25
DN_BETA = (8.0 * DEPTH) ** -0.25
LN_EPS = 1e-5

kernel_name = "hybrid_gmlp_chunkattn_peer_deepnorm"


def layer_norm(x, g, b):
    xf = x.astype(jnp.float32)
    mu = xf.mean(-1, keepdims=True)
    var = jnp.square(xf - mu).mean(-1, keepdims=True)
    y = (xf - mu) * lax.rsqrt(var + LN_EPS)
    return (y * g.astype(jnp.float32) + b.astype(jnp.float32)).astype(x.dtype)


def gmlp_chunk_mask():
    c = np.arange(A_BLOCK) // CHUNK
    return jnp.asarray(c[None, :] <= c[:, None])


def spatial_gating_mixer(z, ln_g, ln_b, w_sp, b_sp):
    b_, s_, _ = z.shape
    u, v = jnp.split(z, 2, axis=-1)
    v = layer_norm(v, ln_g, ln_b)
    v = v.reshape(b_, s_ // A_BLOCK, A_BLOCK, A_GROUPS, A_CH)
    w = jnp.where(gmlp_chunk_mask()[None], w_sp, 0)
    s = jnp.einsum('gij,bnjgc->bnigc', w, v) + b_sp.T[None, None, :, :, None]
    return u * s.reshape(b_, s_, D_A)


def chunk_band_attention(q, k, v, rel_bias):
    b_, s_, _ = q.shape
    nc = s_ // CHUNK
    shp = (b_, nc, CHUNK, B_HEADS, B_HEAD_DIM)
    q = q.reshape(shp)
    k = k.reshape(shp)
    v = v.reshape(shp)
    pad = ((0, 0), (B_LEFT_CHUNKS, 0), (0, 0), (0, 0), (0, 0))
    band = jnp.arange(nc)[:, None] + jnp.arange(B_LEFT_CHUNKS + 1)[None, :]
    kb = jnp.pad(k, pad)[:, band].reshape(b_, nc, B_BAND, B_HEADS, B_HEAD_DIM)
    vb = jnp.pad(v, pad)[:, band].reshape(b_, nc, B_BAND, B_HEADS, B_HEAD_DIM)
    scores = jnp.einsum('bcihd,bcmhd->bchim', q, kb).astype(jnp.float32) * (B_HEAD_DIM ** -0.5)
    qi = jnp.arange(CHUNK)[:, None]
    km = jnp.arange(B_BAND)[None, :]
    rel = jnp.clip(qi + B_LEFT_CHUNKS * CHUNK - km, -REL_CLIP, REL_CLIP) + REL_CLIP
    bias = rel_bias.astype(jnp.float32)[:, rel]
    key_pos = (jnp.arange(nc)[:, None] - B_LEFT_CHUNKS) * CHUNK + jnp.arange(B_BAND)[None, :]
    valid = key_pos >= 0
    scores = jnp.where(valid[None, :, None, None, :], scores + bias[None, None], -1e30)
    p = jax.nn.softmax(scores, axis=-1).astype(v.dtype)
    o = jnp.einsum('bchim,bcmhd->bcihd', p, vb)
    return o.reshape(b_, s_, D_B)


def memory_cross_attention(h, mem, w_q, w_k, w_v, w_o):
    b_, s_, _ = h.shape
    m_ = mem.shape[1]
    q = (h @ w_q).reshape(b_, s_, X_HEADS, X_HEAD_DIM)
    k = (mem @ w_k).reshape(b_, m_, X_HEADS, X_HEAD_DIM)
    v = (mem @ w_v).reshape(b_, m_, X_HEADS, X_HEAD_DIM)
    scores = jnp.einsum('bshd,bmhd->bhsm', q, k).astype(jnp.float32) * (X_HEAD_DIM ** -0.5)
    p = jax.nn.softmax(scores, axis=-1).astype(v.dtype)
    o = jnp.einsum('bhsm,bmhd->bshd', p, v).reshape(b_, s_, D_MODEL)
    return o @ w_o


def peer_ffn(h, w_pq, sub_keys, expert_u, expert_v):
    b_, s_, d = h.shape
    t = b_ * s_
    xf = h.reshape(t, d)
    q = (xf @ w_pq).reshape(t, PEER_HEADS, 2, PEER_HALF)
    s = jnp.einsum('thpd,hpkd->thpk', q, sub_keys).astype(jnp.float32)
    sv, si = lax.top_k(s, PEER_TOPK)
    comb = (sv[:, :, 0, :, None] + sv[:, :, 1, None, :]).reshape(t, PEER_HEADS, PEER_TOPK * PEER_TOPK)
    gv, gp = lax.top_k(comb, PEER_TOPK)
    i1 = jnp.take_along_axis(si[:, :, 0], gp // PEER_TOPK, axis=-1)
    i2 = jnp.take_along_axis(si[:, :, 1], gp % PEER_TOPK, axis=-1)
    n_blk = t // PEER_TOKEN_BLOCK
    idx = (i1 * PEER_KEYS + i2).reshape(n_blk, PEER_TOKEN_BLOCK, PEER_HEADS * PEER_TOPK)
    g = jax.nn.softmax(gv, axis=-1).astype(h.dtype).reshape(n_blk, PEER_TOKEN_BLOCK, PEER_HEADS * PEER_TOPK)
    xb = xf.reshape(n_blk, PEER_TOKEN_BLOCK, d)

    def block(args):
        x_blk, idx_blk, g_blk = args
        u = expert_u[idx_blk]
        a = g_blk * jax.nn.gelu(jnp.einsum('tkd,td->tk', u, x_blk), approximate=False)
        return jnp.einsum('tk,tkd->td', a, expert_v[idx_blk])

    out = lax.map(block, (xb, idx, g))
    return out.reshape(b_, s_, d)


def setup_inputs(seed: int = 0) -> dict:
    key = jax.random.key(seed)
    ks = jax.random.split(key, 32)
    f32 = jnp.float32
    nrm = lambda k, shp, sc: jax.random.normal(k, shp, f32) * sc
    gain = lambda k, shp: 1.0 + 0.05 * jax.random.normal(k, shp, f32)
    L = DEPTH
    return {
        "x": nrm(ks[0], (BATCH, SEQ, D_MODEL), 1.0),
        "mem": nrm(ks[1], (BATCH, MEM_LEN, D_MODEL), 1.0),
        "ln_in_g": gain(ks[2], (D_MODEL,)),
        "ln_in_b": nrm(ks[3], (D_MODEL,), 0.05),
        "w_in": nrm(ks[4], (L, D_MODEL, N_IN), D_MODEL ** -0.5),
        "gate_ln_g": gain(ks[5], (L, D_A)),
        "gate_ln_b": nrm(ks[6], (L, D_A), 0.05),
        "w_sp": nrm(ks[7], (L, A_GROUPS, A_BLOCK, A_BLOCK), A_BLOCK ** -0.5),
        "b_sp": gain(ks[8], (L, A_GROUPS, A_BLOCK)),
        "rel_bias": nrm(ks[9], (L, B_HEADS, 2 * REL_CLIP + 1), 0.1),
        "w_out": nrm(ks[10], (L, D_MIX, D_MODEL), DN_BETA * D_MIX ** -0.5),
        "ln1_g": gain(ks[11], (L, D_MODEL)),
        "ln1_b": nrm(ks[12], (L, D_MODEL), 0.05),
        "w_xq": nrm(ks[13], (L, D_MODEL, D_MODEL), D_MODEL ** -0.5),
        "w_xk": nrm(ks[14], (L, D_MODEL, D_MODEL), D_MODEL ** -0.5),
        "w_xv": nrm(ks[15], (L, D_MODEL, D_MODEL), DN_BETA * D_MODEL ** -0.5),
        "w_xo": nrm(ks[16], (L, D_MODEL, D_MODEL), DN_BETA * D_MODEL ** -0.5),
        "ln2_g": gain(ks[17], (L, D_MODEL)),
        "ln2_b": nrm(ks[18], (L, D_MODEL), 0.05),
        "w_pq": nrm(ks[19], (L, D_MODEL, PEER_HEADS * PEER_D_KEY), D_MODEL ** -0.5),
        "sub_keys": nrm(ks[20], (L, PEER_HEADS, 2, PEER_KEYS, PEER_HALF), PEER_HALF ** -0.5),
        "expert_u": nrm(ks[21], (L, PEER_EXPERTS, D_MODEL), D_MODEL ** -0.5),
        "expert_v": nrm(ks[22], (L, PEER_EXPERTS, D_MODEL), DN_BETA),
        "ln3_g": gain(ks[23], (L, D_MODEL)),
        "ln3_b": nrm(ks[24], (L, D_MODEL), 0.05),
    }


def reference(x, mem, ln_in_g, ln_in_b, w_in, gate_ln_g, gate_ln_b, w_sp, b_sp, rel_bias,
              w_out, ln1_g, ln1_b, w_xq, w_xk, w_xv, w_xo, ln2_g, ln2_b,
              w_pq, sub_keys, expert_u, expert_v, ln3_g, ln3_b):
    h = layer_norm(x, ln_in_g, ln_in_b)
    split_at = [2 * D_A, 2 * D_A + D_B, 2 * D_A + 2 * D_B]
    for l in range(DEPTH):
        proj = h @ w_in[l]
        z_a, q_b, k_b, v_b = jnp.split(proj, split_at, axis=-1)
        y_a = spatial_gating_mixer(jax.nn.gelu(z_a, approximate=False),
                                   gate_ln_g[l], gate_ln_b[l], w_sp[l], b_sp[l])
        y_b = chunk_band_attention(q_b, k_b, v_b, rel_bias[l])
        mix = jnp.concatenate([y_a, y_b], axis=-1) @ w_out[l]
        h = layer_norm(DN_ALPHA * h + mix, ln1_g[l], ln1_b[l])
        xa = memory_cross_attention(h, mem, w_xq[l], w_xk[l], w_xv[l], w_xo[l])
        h = layer_norm(DN_ALPHA * h + xa, ln2_g[l], ln2_b[l])
        ff = peer_ffn(h, w_pq[l], sub_keys[l], expert_u[l], expert_v[l])
        h = layer_norm(DN_ALPHA * h + ff, ln3_g[l], ln3_b[l])
    return h
```

```cpp
#include <hip/hip_runtime.h>
#include <cstdio>
#include <cstdint>

#ifndef DBG_MASK
#define DBG_MASK 0
#endif
#ifndef DBG_STAT
#define DBG_STAT 0
#endif
#ifndef MK_N_LAUNCHES
#define MK_N_LAUNCHES 1
#endif

namespace pg8 {
#define PG8_LAS __attribute__((address_space(3)))
typedef unsigned short bf16_t;
typedef short bf16x8 __attribute__((ext_vector_type(8)));
typedef float f32x4 __attribute__((ext_vector_type(4)));
typedef unsigned u32x4 __attribute__((ext_vector_type(4)));
typedef unsigned u32x2 __attribute__((ext_vector_type(2)));
constexpr int BM = 256, BK = 64, HALF = 128, HTB = HALF * BK * 2  , STAGE_BYTES = 8 * HTB, NXCD = 8, WGM = 8;

__host__ __device__ __forceinline__ int lds_byte(int r, int c) { const int st = (r >> 4) * 2 + (c >> 5), rr = r & 15, cc = c & 31, ob = rr * 64 + cc * 2; return st * 1024 + (ob ^ (((ob >> 9) & 1) << 5)); }
__host__ __device__ __forceinline__ void stage_rc(int b, int& R, int& C) { const int st = b / 1024, sb = b % 1024, swz = sb ^ (((sb >> 9) & 1) << 5); R = (st >> 1) * 16 + swz / 64; C = (st & 1) * 32 + (swz % 64) / 2; }
__host__ __device__ __forceinline__ int perm32(int rho) { const int n = rho >> 4, i = rho & 15; return 8 * (i >> 2) + 4 * n + (i & 3); }

struct Unit { int pm, pn, g; };
struct Gemm2 { const bf16_t* A0; const bf16_t* B0; const bf16_t* A1; const bf16_t* B1; int K; };

struct Order2 {
    int nM0, nN0, nwg0, nM1, nN1, nwg1, G, c;
    __device__ void init(int M0, int N0, int M1, int N1, int G_, int c_) { nM0 = M0 / BM; nN0 = N0 / BM; nwg0 = nM0 * nN0; nM1 = M1 / BM; nN1 = N1 / BM; nwg1 = nM1 * nN1; G = G_; c = c_; }
    __device__ __forceinline__ bool next(int i, Unit& u) const {
        const int L = i * G + c; const bool in0 = L < nwg0;
        int wgid = in0 ? L : 0; { const int q = nwg0 / NXCD, r = nwg0 % NXCD, xcd = wgid % NXCD, off = wgid / NXCD; wgid = (xcd < r ? xcd * (q + 1) : r * (q + 1) + (xcd - r) * q) + off; }
        const int nig = WGM * nN0, gid = wgid / nig, fm = gid * WGM, gsz = (nM0 - fm) < WGM ? (nM0 - fm) : WGM;
        const int pm0 = fm + ((wgid % nig) % gsz), pn0 = (wgid % nig) / gsz;
        const int L1 = in0 ? 0 : L - nwg0, d1 = nM1 > 0 ? nM1 : 1;
        u.pm = in0 ? pm0 : (L1 % d1); u.pn = in0 ? pn0 : (L1 / d1); u.g = in0 ? 0 : 1;
        return in0 || (L - nwg0 < nwg1);
    }
    __device__ __forceinline__ void a_ready(const Unit&) const {}
    __device__ __forceinline__ void done(const Unit&) const {}
};

__device__ __forceinline__ unsigned cvt_pk_bf16(float lo, float hi) { unsigned r; asm volatile("v_cvt_pk_bf16_f32 %0, %1, %2" : "=v"(r) : "v"(lo), "v"(hi)); return r; }
typedef float f32x2 __attribute__((ext_vector_type(2)));
__device__ __forceinline__ f32x2 gelu_pk(f32x2 v) {
    const f32x2 av = __builtin_elementwise_abs(v), d = av * 0.2316418882f + 1.0f;
    f32x2 t; t.x = __builtin_amdgcn_rcpf(d.x); t.y = __builtin_amdgcn_rcpf(d.y);
    f32x2 q = t * 0.5307027145f + (-0.7265760135f); q = q * t + 0.7107068705f; q = q * t + (-0.142248368f); q = q * t + 0.127414796f; q = q * t;
    const f32x2 s = (v * v) * (-0.72134752044f);
    f32x2 e; e.x = __builtin_amdgcn_exp2f(s.x); e.y = __builtin_amdgcn_exp2f(s.y);
    const f32x2 m = v * (q * e), r = v - m;
    f32x2 o; o.x = v.x < 0.f ? m.x : r.x; o.y = v.y < 0.f ? m.y : r.y; return o;
}
__device__ __forceinline__ float gelu1(float v) { f32x2 x = {v, v}; return gelu_pk(x).x; }

struct EpiProj {
    static constexpr bool PERM = true, AFTER_DRAIN = false;
    bf16_t* O0; int ld0; bf16_t* O1; int ld1; float qscale; int gelu_cols, scale_cols;
    __device__ __forceinline__ void operator()(const f32x4 (&acc)[2][2][4][2], const Unit& u, int wr, int wc, int fr, int fq) const {
        const int row0 = u.pm * BM + wr * 64 + fr; const int colt = u.pn * BM;
        bf16_t* base = u.g ? O1 : O0; const int ldc = u.g ? ld1 : ld0;
        const int mode = u.g ? 0 : (colt < gelu_cols ? 1 : (colt < scale_cols ? 2 : 0));
        const float sc = mode == 2 ? qscale : 1.f;
        const int col0 = colt + wc * 32 + 8 * fq;
#pragma unroll
        for (int ai = 0; ai < 2; ++ai)
#pragma unroll
            for (int m = 0; m < 4; ++m) { bf16_t* rowp = base + (size_t)(row0 + ai * HALF + m * 16) * ldc + col0;
#pragma unroll
                for (int bj = 0; bj < 2; ++bj) { f32x4 v0 = acc[ai][bj][m][0], v1 = acc[ai][bj][m][1];
                    if (mode == 1) { f32x2 a = gelu_pk((f32x2){v0[0], v0[1]}), b = gelu_pk((f32x2){v0[2], v0[3]}), c = gelu_pk((f32x2){v1[0], v1[1]}), d = gelu_pk((f32x2){v1[2], v1[3]});
                        v0 = (f32x4){a.x, a.y, b.x, b.y}; v1 = (f32x4){c.x, c.y, d.x, d.y}; }
                    v0 = v0 * sc; v1 = v1 * sc; u32x4 w; w.x = cvt_pk_bf16(v0[0], v0[1]); w.y = cvt_pk_bf16(v0[2], v0[3]); w.z = cvt_pk_bf16(v1[0], v1[1]); w.w = cvt_pk_bf16(v1[2], v1[3]);
                    *(u32x4*)(rowp + bj * HALF) = w; } }
    }
};
struct EpiZ {
    static constexpr bool PERM = false, AFTER_DRAIN = false;
    const bf16_t* res; float* z; int ldc; float alpha; float accw;
    __device__ __forceinline__ void operator()(const f32x4 (&acc)[2][2][4][2], const Unit& u, int wr, int wc, int fr, int fq) const {
        const int col0 = u.pn * BM + wc * 32 + 4 * fq;
#pragma unroll
        for (int ai = 0; ai < 2; ++ai)
#pragma unroll
            for (int m = 0; m < 4; ++m) { const size_t off = (size_t)(u.pm * BM + ai * HALF + wr * 64 + m * 16 + fr) * ldc + col0;
#pragma unroll
                for (int bj = 0; bj < 2; ++bj)
#pragma unroll
                    for (int n = 0; n < 2; ++n) { const u32x2 rb = *(const u32x2*)(res + off + bj * HALF + n * 16);
                        f32x4 r; r[0] = __uint_as_float(rb.x << 16); r[1] = __uint_as_float(rb.x & 0xffff0000u); r[2] = __uint_as_float(rb.y << 16); r[3] = __uint_as_float(rb.y & 0xffff0000u);
                        *(f32x4*)(z + off + bj * HALF + n * 16) = r * alpha + acc[ai][bj][m][n] * accw; } }
    }
};

template <class Epi, class Sched, bool ALIGN_EPI = false, bool SP2 = false>
__device__ __forceinline__ void gemm_phase(PG8_LAS unsigned char* lds, const Gemm2 g, const Sched& S, const Epi& E) {
    const int tid = threadIdx.x, wid = __builtin_amdgcn_readfirstlane(tid >> 6), lane = tid & 63, wr = wid >> 2, wc = wid & 3, fr = lane & 15, fq = lane >> 4;
    const int K = g.K, nt = K / BK;
    unsigned voffA[2], voffB[2];
#pragma unroll
    for (int i = 0; i < 2; ++i) { int R, C; stage_rc(tid * 16 + i * 8192, R, C); const int Rb = Epi::PERM ? ((R & ~31) + perm32(R & 31)) : R;
        voffA[i] = (unsigned)(R * K + C) * 2u; voffB[i] = (unsigned)(Rb * K + C) * 2u; }
    const size_t kstep = (size_t)(BK * 2);
    const size_t hstep = (size_t)HALF * K * 2;
    const size_t tstep = 2 * hstep;
    const unsigned ldsw = (unsigned)wid * 1024u;
    const int aoff = lds_byte(wr * 64 + fr, fq * 8), boff = lds_byte(wc * 32 + fr, fq * 8);
#define PG8_SA(b, h) (((b) * 2 + (h)) * HTB)
#define PG8_SB(b, h) ((4 + (b) * 2 + (h)) * HTB)
#define PG8_STAGE(bufoff, gbase, voff) do { _Pragma("unroll") for (int _i = 0; _i < 2; ++_i) \
        __builtin_amdgcn_global_load_lds((const unsigned*)((const char*)(gbase) + (voff)[_i]), (PG8_LAS unsigned*)(lds + (bufoff) + ldsw + _i * 8192), 16, 0, 0); } while (0)
#define PG8_LDA(dst, b, h) do { _Pragma("unroll") for (int m = 0; m < 4; ++m) _Pragma("unroll") for (int k = 0; k < 2; ++k) dst[m][k] = *(const PG8_LAS bf16x8*)(lds + PG8_SA(b, h) + aoff + m * 2048 + k * 1024); } while (0)
#define PG8_LDB(dst, b, h) do { _Pragma("unroll") for (int n = 0; n < 2; ++n) _Pragma("unroll") for (int k = 0; k < 2; ++k) dst[n][k] = *(const PG8_LAS bf16x8*)(lds + PG8_SB(b, h) + boff + n * 2048 + k * 1024); } while (0)
#define PG8_MMA(ai, bj, At, Bt) do { __builtin_amdgcn_s_setprio(1); _Pragma("unroll") for (int m = 0; m < 4; ++m) _Pragma("unroll") for (int n = 0; n < 2; ++n) _Pragma("unroll") for (int k = 0; k < 2; ++k) \
        acc[ai][bj][m][n] = __builtin_amdgcn_mfma_f32_16x16x32_bf16(Bt[n][k], At[m][k], acc[ai][bj][m][n], 0, 0, 0); __builtin_amdgcn_s_setprio(0); } while (0)
#define PG8_WAIT_V(n) asm volatile("s_waitcnt vmcnt(" #n ")" ::: "memory")
#define PG8_WAIT_L(n) asm volatile("s_waitcnt lgkmcnt(" #n ")" ::: "memory")
#define PG8_BAR __builtin_amdgcn_s_barrier()
#define PG8_SCHED __builtin_amdgcn_sched_barrier(0)
    Unit cur, nxt; int ui = 0;
    if (!S.next(0, cur)) return;
    f32x4 acc[2][2][4][2];
#pragma unroll
    for (int a = 0; a < 2; ++a)
#pragma unroll
        for (int b = 0; b < 2; ++b)
#pragma unroll
            for (int m = 0; m < 4; ++m)
#pragma unroll
                for (int n = 0; n < 2; ++n) acc[a][b][m][n] = (f32x4){0.f, 0.f, 0.f, 0.f};
    bf16x8 At[4][2], B0[2][2], B1[2][2];
    const char* cA = (const char*)(cur.g ? g.A1 : g.A0) + (size_t)cur.pm * tstep; const char* cB = (const char*)(cur.g ? g.B1 : g.B0) + (size_t)cur.pn * tstep;
    S.a_ready(cur);
    if constexpr (SP2) {
        PG8_STAGE(PG8_SB(0, 0), cB, voffB); PG8_STAGE(PG8_SB(0, 1), cB + hstep, voffB); PG8_STAGE(PG8_SA(0, 0), cA, voffA); PG8_STAGE(PG8_SA(0, 1), cA + hstep, voffA);
        if (wr == 1) PG8_BAR;
        PG8_WAIT_V(2); PG8_BAR;
        PG8_STAGE(PG8_SB(1, 0), cB + kstep, voffB); PG8_STAGE(PG8_SA(1, 0), cA + kstep, voffA); PG8_STAGE(PG8_SB(1, 1), cB + hstep + kstep, voffB);
        PG8_WAIT_V(6); PG8_BAR;
    } else {
        PG8_STAGE(PG8_SB(0, 0), cB, voffB); PG8_STAGE(PG8_SA(0, 0), cA, voffA); PG8_STAGE(PG8_SB(0, 1), cB + hstep, voffB); PG8_STAGE(PG8_SA(0, 1), cA + hstep, voffA);
        if (wr == 1) PG8_BAR;
        PG8_WAIT_V(4); PG8_BAR;
        PG8_STAGE(PG8_SB(1, 0), cB + kstep, voffB); PG8_STAGE(PG8_SA(1, 0), cA + kstep, voffA); PG8_STAGE(PG8_SB(1, 1), cB + hstep + kstep, voffB);
        PG8_WAIT_V(6); PG8_BAR;
    }
    for (;;) {
        const bool has_next = S.next(ui + 1, nxt);
        const char* nA = has_next ? (const char*)(nxt.g ? g.A1 : g.A0) + (size_t)nxt.pm * tstep : cA; const char* nB = has_next ? (const char*)(nxt.g ? g.B1 : g.B0) + (size_t)nxt.pn * tstep : cB;
        for (int t = 0; t < nt; t += 2) {
            const bool last = (t == nt - 2);
            const char* a1 = cA + (size_t)(t + 1) * kstep;
            const char* a2 = last ? nA : cA + (size_t)(t + 2) * kstep; const char* b2 = last ? nB : cB + (size_t)(t + 2) * kstep;
            const char* a3 = a2 + kstep; const char* b3 = b2 + kstep;
            if (last && has_next) S.a_ready(nxt);
            if constexpr (SP2) {
            PG8_LDB(B0, 0, 0); PG8_LDB(B1, 0, 1); PG8_SCHED; PG8_LDA(At, 0, 0); PG8_STAGE(PG8_SA(1, 1), a1 + hstep, voffA);
            PG8_WAIT_V(8); PG8_WAIT_L(0); PG8_BAR; PG8_MMA(0, 0, At, B0); PG8_MMA(0, 1, At, B1); PG8_BAR; PG8_SCHED;
            PG8_LDA(At, 0, 1); PG8_STAGE(PG8_SB(0, 0), b2, voffB); PG8_STAGE(PG8_SB(0, 1), b2 + hstep, voffB); PG8_STAGE(PG8_SA(0, 0), a2, voffA);
            PG8_WAIT_V(8); PG8_WAIT_L(0); PG8_BAR; PG8_MMA(1, 0, At, B0); PG8_MMA(1, 1, At, B1); PG8_BAR; PG8_SCHED;
            PG8_LDB(B0, 1, 0); PG8_LDB(B1, 1, 1); PG8_SCHED; PG8_LDA(At, 1, 0); PG8_STAGE(PG8_SA(0, 1), a2 + hstep, voffA);
            PG8_WAIT_V(8); PG8_WAIT_L(0); PG8_BAR; PG8_MMA(0, 0, At, B0); PG8_MMA(0, 1, At, B1); PG8_BAR; PG8_SCHED;
            PG8_LDA(At, 1, 1); PG8_STAGE(PG8_SB(1, 0), b3, voffB); PG8_STAGE(PG8_SB(1, 1), b3 + hstep, voffB); PG8_STAGE(PG8_SA(1, 0), a3, voffA);
            PG8_WAIT_V(8); PG8_WAIT_L(0); PG8_BAR; PG8_MMA(1, 0, At, B0); PG8_MMA(1, 1, At, B1); PG8_BAR; PG8_SCHED;
            } else {
            PG8_LDB(B0, 0, 0); PG8_SCHED; PG8_LDA(At, 0, 0); PG8_STAGE(PG8_SA(1, 1), a1 + hstep, voffA);
            PG8_WAIT_L(8); PG8_BAR; PG8_WAIT_L(0); PG8_MMA(0, 0, At, B0); PG8_BAR; PG8_SCHED;
            PG8_LDB(B1, 0, 1); PG8_STAGE(PG8_SB(0, 0), b2, voffB);
            PG8_BAR; PG8_WAIT_L(0); PG8_MMA(0, 1, At, B1); PG8_BAR;
            PG8_LDA(At, 0, 1); PG8_STAGE(PG8_SA(0, 0), a2, voffA);
            PG8_BAR; PG8_WAIT_L(0); PG8_MMA(1, 0, At, B0); PG8_BAR; PG8_SCHED;
            PG8_STAGE(PG8_SB(0, 1), b2 + hstep, voffB);
            PG8_WAIT_V(6); PG8_BAR; PG8_MMA(1, 1, At, B1); PG8_BAR;
            PG8_LDB(B0, 1, 0); PG8_SCHED; PG8_LDA(At, 1, 0); PG8_STAGE(PG8_SA(0, 1), a2 + hstep, voffA);
            PG8_WAIT_L(8); PG8_BAR; PG8_WAIT_L(0); PG8_MMA(0, 0, At, B0); PG8_BAR; PG8_SCHED;
            PG8_LDB(B1, 1, 1); PG8_STAGE(PG8_SB(1, 0), b3, voffB);
            PG8_BAR; PG8_WAIT_L(0); PG8_MMA(0, 1, At, B1); PG8_BAR;
            PG8_LDA(At, 1, 1); PG8_STAGE(PG8_SA(1, 0), a3, voffA);
            PG8_BAR; PG8_WAIT_L(0); PG8_MMA(1, 0, At, B0); PG8_BAR; PG8_SCHED;
            PG8_STAGE(PG8_SB(1, 1), b3 + hstep, voffB);
            PG8_WAIT_V(6); PG8_BAR; PG8_MMA(1, 1, At, B1); PG8_BAR;
            }
        }
        if constexpr (ALIGN_EPI) { if (wr == 0) PG8_BAR; }
        if constexpr (!Epi::AFTER_DRAIN) { E(acc, cur, wr, wc, fr, fq); S.done(cur); }
        if (!has_next) break;
#pragma unroll
        for (int a = 0; a < 2; ++a)
#pragma unroll
            for (int b = 0; b < 2; ++b)
#pragma unroll
                for (int m = 0; m < 4; ++m)
#pragma unroll
                    for (int n = 0; n < 2; ++n) acc[a][b][m][n] = (f32x4){0.f, 0.f, 0.f, 0.f};
        cur = nxt; cA = nA; cB = nB; ++ui;
        if constexpr (ALIGN_EPI) { if (wr == 1) PG8_BAR; }
    }
    PG8_WAIT_V(0);
    if constexpr (!ALIGN_EPI) { if (wr == 0) PG8_BAR; }
    PG8_BAR;
    if constexpr (Epi::AFTER_DRAIN) { E.fused(acc, cur, wr, wc, fr, fq, lds, wid, lane); S.done(cur); }
#undef PG8_SA
#undef PG8_SB
#undef PG8_STAGE
#undef PG8_LDA
#undef PG8_LDB
#undef PG8_MMA
#undef PG8_WAIT_V
#undef PG8_WAIT_L
#undef PG8_BAR
#undef PG8_SCHED
}
}

#define GAS __attribute__((address_space(1)))
#define LAS __attribute__((address_space(3)))
typedef unsigned short bf16;
typedef unsigned v4u __attribute__((ext_vector_type(4)));
typedef float f32x4 __attribute__((ext_vector_type(4)));
typedef short bf16x8 __attribute__((ext_vector_type(8)));
typedef GAS unsigned gu32;
typedef GAS unsigned long long gu64;
#define RLX_AGENT __ATOMIC_RELAXED, __HIP_MEMORY_SCOPE_AGENT
#define LDS_WAIT() asm volatile("s_waitcnt lgkmcnt(0)" ::: "memory")
#define VM_WAIT() asm volatile("s_waitcnt vmcnt(0)" ::: "memory")
__device__ __forceinline__ unsigned long long rt() { return __builtin_amdgcn_s_memrealtime(); }
__device__ __forceinline__ unsigned f2bf(float f) { unsigned u = __builtin_bit_cast(unsigned, f); return (u + 0x7fffu + ((u >> 16) & 1u)) >> 16; }
__device__ __forceinline__ unsigned pk2(float lo, float hi) { return f2bf(lo) | (f2bf(hi) << 16); }

#define XB_TMO      128
#define XB_XCNT(j)  (256  + 64 * (j))
#define XB_XSUB(j)  (1280 + 64 * (j))
#define XB_XGEN(j)  (2304 + 64 * (j))
#define XB_TOP      3328
#define XB_TOPGEN   3392
#define XCD_BAR_WORDS 3456
#define XB_SPIN_CAP (1u << 18)

__device__ __forceinline__ unsigned xb_ld(unsigned* p)              { return __hip_atomic_load(p, __ATOMIC_RELAXED, __HIP_MEMORY_SCOPE_AGENT); }
__device__ __forceinline__ unsigned xb_add(unsigned* p, unsigned v) { return __hip_atomic_fetch_add(p, v, __ATOMIC_RELAXED, __HIP_MEMORY_SCOPE_AGENT); }
__device__ __forceinline__ unsigned xb_xcc_id() { return (unsigned)__builtin_amdgcn_s_getreg((3 << 11) | 20) & 0xFu; }
#define XB_SPIN(cond, bar) do { unsigned _sp = 0; while (cond) { __builtin_amdgcn_s_sleep(1); \
    if ((++_sp & 255u) == 0u) { if (xb_ld(&(bar)[XB_TMO])) break; if (_sp > XB_SPIN_CAP) { atomicAdd(&(bar)[XB_TMO], 1u); break; } } } } while (0)

struct XcdBarrier {
    unsigned* bar; unsigned x;
    volatile LAS unsigned* st;
};

__device__ __forceinline__ XcdBarrier xcd_barrier_post(unsigned* bar, volatile LAS unsigned* st) {
    XcdBarrier b; b.bar = bar; b.x = xb_xcc_id(); b.st = st;
    if (threadIdx.x == 0) (void)xb_add(&bar[XB_XCNT(b.x)], 1u);
    return b;
}
__device__ __forceinline__ void xcd_barrier_complete(unsigned* bar, unsigned x, unsigned& nloc, unsigned& nx) {
    const unsigned G = gridDim.x * gridDim.y * gridDim.z;
    unsigned sum, cnt, mine, sp = 0u;
    for (;;) {
        sum = 0u; cnt = 0u; mine = 0u;
#pragma unroll
        for (unsigned j = 0; j < 16; ++j) { const unsigned c = xb_ld(&bar[XB_XCNT(j)]); sum += c; cnt += (c > 0u) ? 1u : 0u; mine = (j == x) ? c : mine; }
        if (sum == G) break;
        __builtin_amdgcn_s_sleep(1);
        if ((++sp & 255u) == 0u) { if (xb_ld(&bar[XB_TMO])) break; if (sp > XB_SPIN_CAP) { atomicAdd(&bar[XB_TMO], 1u); break; } }
    }
    nloc = mine > 0u ? mine : 1u; nx = cnt > 0u ? cnt : 1u;
}

__device__ __forceinline__ void xcd_barrier(const XcdBarrier& b) {
    asm volatile("s_waitcnt vmcnt(0)" ::: "memory");
    __syncthreads();
    if (threadIdx.x == 0) {
        unsigned* bar = b.bar;
        __builtin_amdgcn_s_waitcnt(0);
        unsigned nloc = b.st[0], nx = b.st[1];
        if (nloc == 0u) { xcd_barrier_complete(bar, b.x, nloc, nx); b.st[0] = nloc; b.st[1] = nx; }
        const unsigned old = xb_add(&bar[XB_XSUB(b.x)], 1u);
        const unsigned gen = old / nloc;
        if (old + 1u == (gen + 1u) * nloc) {
            __builtin_amdgcn_fence(__ATOMIC_RELEASE, "agent");
            asm volatile("s_waitcnt vmcnt(0)" ::: "memory");
            const unsigned og = xb_add(&bar[XB_TOP], 1u);
            const unsigned tg = og / nx;
            if (og + 1u == (tg + 1u) * nx) xb_add(&bar[XB_TOPGEN], 1u);
            else XB_SPIN(xb_ld(&bar[XB_TOPGEN]) == tg, bar);
            __builtin_amdgcn_fence(__ATOMIC_ACQUIRE, "agent");
            xb_add(&bar[XB_XGEN(b.x)], 1u);
            asm volatile("s_waitcnt vmcnt(0)" ::: "memory");
        } else {
            XB_SPIN(xb_ld(&bar[XB_XGEN(b.x)]) == gen, bar);
            __builtin_amdgcn_fence(__ATOMIC_ACQUIRE, "agent");
            asm volatile("s_waitcnt vmcnt(0)" ::: "memory");
        }
    }
    __syncthreads();
}

constexpr int NWAVES = 8, NTHREADS = 512;
constexpr int BATCH = 8, SEQ = 2048, DM = 1024, T = BATCH * SEQ;
constexpr int NIN = 2560, MEMLEN = 256, TMEM = BATCH * MEMLEN;
constexpr int NEXP = 16384;
constexpr float LN_EPS = 1e-5f;
constexpr float DN_ALPHA = 1.189207115002721f;
constexpr float LOG2E = 1.4426950408889634f;
constexpr float QB_SCALE = 0.125f * LOG2E;
constexpr float XQ_SCALE = 0.0625f * LOG2E;

constexpr size_t MiB = 1u << 20;
constexpr size_t WS_CTL = 0, CTL_ZERO_BYTES = 1 * MiB;
constexpr size_t WS_WIN = 1 * MiB;
constexpr size_t WS_WOUT = 6 * MiB;
constexpr size_t WS_WXQ = 8 * MiB;
constexpr size_t WS_WXKV = 10 * MiB;
constexpr size_t WS_WXO = 14 * MiB;
constexpr size_t WS_WPQ = 16 * MiB;
constexpr size_t WS_SKB = 20 * MiB;
constexpr size_t WS_WSPM = 20 * MiB + 512 * 1024;
constexpr size_t WS_EU = 21 * MiB;
constexpr size_t WS_EV = 53 * MiB;
constexpr size_t WS_A = 85 * MiB;
constexpr size_t WS_PROJ = WS_A, WS_XQ = WS_A, WS_XO = WS_A + 32 * MiB, WS_PQ = WS_A;
constexpr size_t WS_B = 165 * MiB;
constexpr size_t WS_C = 197 * MiB;
constexpr size_t WS_MEMB = 229 * MiB;
constexpr size_t WS_XKV = 233 * MiB;
constexpr size_t WS_RIDX = 241 * MiB;
constexpr size_t WS_RGATE = 245 * MiB;
constexpr size_t WS_END = 253 * MiB;
constexpr int CW_BAR = 4096;

constexpr int SCRATCH_BYTES = 139264;
constexpr int LDSCTL_OFF = SCRATCH_BYTES;
constexpr int LDS_BYTES = SCRATCH_BYTES + 1024;

typedef short s16x4 __attribute__((ext_vector_type(4)));
typedef unsigned u32x2v __attribute__((ext_vector_type(2)));
typedef __bf16 v2bf16 __attribute__((ext_vector_type(2)));

struct Ctx { LAS unsigned char* lds; int tid, lane, wave, vcu, G; };

__device__ __forceinline__ float bf_lo(unsigned u) { return __uint_as_float(u << 16); }
__device__ __forceinline__ float bf_hi(unsigned u) { return __uint_as_float(u & 0xffff0000u); }
__device__ __forceinline__ float wave_sum(float v) {
#pragma unroll
    for (int o = 1; o < 64; o <<= 1) v += __shfl_xor(v, o);
    return v;
}
__device__ __forceinline__ bf16x8 pack8(f32x4 a, f32x4 b) {
    v4u w; w.x = pg8::cvt_pk_bf16(a[0], a[1]); w.y = pg8::cvt_pk_bf16(a[2], a[3]); w.z = pg8::cvt_pk_bf16(b[0], b[1]); w.w = pg8::cvt_pk_bf16(b[2], b[3]);
    return __builtin_bit_cast(bf16x8, w);
}
__device__ __forceinline__ s16x4 tr4(LAS unsigned char* p) { return __builtin_amdgcn_ds_read_tr16_b64_v4i16((LAS s16x4*)p); }
__device__ __forceinline__ bf16x8 cat8(s16x4 lo, s16x4 hi) { return (bf16x8){lo[0], lo[1], lo[2], lo[3], hi[0], hi[1], hi[2], hi[3]}; }
#define MFMA16(a, b, c) __builtin_amdgcn_mfma_f32_16x16x32_bf16((a), (b), (c), 0, 0, 0)

__device__ __forceinline__ void p0_transpose_item(const float* W, int K, int N, bf16* WT, int row_off, LAS float* scr, int item, int lane) {
    const int nblk = N / 32, kb = item / nblk, nb = item % nblk, k0 = 64 * kb, n0 = 32 * nb;
#pragma unroll 8
    for (int i = 0; i < 32; ++i) { const int kk = 2 * i + (lane >> 5); scr[kk * 33 + (lane & 31)] = W[(size_t)(k0 + kk) * N + n0 + (lane & 31)]; }
    LDS_WAIT(); asm volatile("" ::: "memory");
    const int c = lane & 7;
#pragma unroll
    for (int j = 0; j < 4; ++j) { const int n = (lane >> 3) + 8 * j; const LAS float* s = scr + (8 * c) * 33 + n;
        v4u o; o.x = pk2(s[0 * 33], s[1 * 33]); o.y = pk2(s[2 * 33], s[3 * 33]); o.z = pk2(s[4 * 33], s[5 * 33]); o.w = pk2(s[6 * 33], s[7 * 33]);
        *(GAS v4u*)(WT + (size_t)(row_off + n0 + n) * K + k0 + 8 * c) = o; }
    LDS_WAIT(); asm volatile("" ::: "memory");
}
__device__ __forceinline__ void cvt_f32_bf16(const float* src, bf16* dst, size_t n_elems, int gw, int NGW, int lane) {
    const size_t nitems = n_elems / 512;
#pragma unroll 4
    for (size_t it = gw; it < nitems; it += NGW) {
        const GAS f32x4* s = (const GAS f32x4*)(src + it * 512 + lane * 8);
        const f32x4 a = s[0], b = s[1];
        v4u o; o.x = pk2(a[0], a[1]); o.y = pk2(a[2], a[3]); o.z = pk2(b[0], b[1]); o.w = pk2(b[2], b[3]);
        *(GAS v4u*)(dst + it * 512 + lane * 8) = o;
    }
}
__device__ __forceinline__ void ln_row_to_bf16(const float* xrow, const float* gam, const float* bet, bf16* orow, int lane) {
    const GAS f32x4* xr = (const GAS f32x4*)xrow + lane;
    f32x4 v[4]; float s = 0.f;
#pragma unroll
    for (int j = 0; j < 4; ++j) { v[j] = xr[64 * j]; s += (v[j][0] + v[j][1]) + (v[j][2] + v[j][3]); }
    const float mean = wave_sum(s) * (1.f / DM); float s2 = 0.f;
#pragma unroll
    for (int j = 0; j < 4; ++j) { v[j] = v[j] - mean; s2 += (v[j][0] * v[j][0] + v[j][1] * v[j][1]) + (v[j][2] * v[j][2] + v[j][3] * v[j][3]); }
    const float rstd = 1.f / sqrtf(wave_sum(s2) * (1.f / DM) + LN_EPS);
    GAS unsigned long long* o8 = (GAS unsigned long long*)orow + lane;
#pragma unroll
    for (int j = 0; j < 4; ++j) { const f32x4 gg = *((const GAS f32x4*)gam + lane + 64 * j), bb = *((const GAS f32x4*)bet + lane + 64 * j);
        const f32x4 y = v[j] * rstd * gg + bb;
        o8[64 * j] = (unsigned long long)pk2(y[0], y[1]) | ((unsigned long long)pk2(y[2], y[3]) << 32); }
}
struct P0Args { const float *x, *mem, *ln_g, *ln_b, *w_in, *w_sp, *w_out, *w_xq, *w_xk, *w_xv, *w_xo, *w_pq, *sub_keys, *eu, *ev;
                bf16 *WIN, *WOUT, *WXQ, *WXKV, *WXO, *WPQ, *SKB, *WSPM, *EU, *EV, *H0, *MEMB; };
__device__ __forceinline__ void p0_prologue(const Ctx& C, const P0Args& a) {
    LAS float* scr = (LAS float*)(C.lds + C.wave * 16384);
    const int gw = C.vcu * NWAVES + C.wave, NGW = C.G * NWAVES, lane = C.lane;
    constexpr int I_IN = 16 * (NIN / 32), I_SQ = 16 * (DM / 32), I_PQ = 16 * (2048 / 32);
    constexpr int NITEMS = I_IN + 5 * I_SQ + I_PQ;
    for (int it = gw; it < NITEMS; it += NGW) {
        int r = it;
        if (r < I_IN) { p0_transpose_item(a.w_in, DM, NIN, a.WIN, 0, scr, r, lane); continue; } r -= I_IN;
        if (r < I_SQ) { p0_transpose_item(a.w_out, DM, DM, a.WOUT, 0, scr, r, lane); continue; } r -= I_SQ;
        if (r < I_SQ) { p0_transpose_item(a.w_xq, DM, DM, a.WXQ, 0, scr, r, lane); continue; } r -= I_SQ;
        if (r < I_SQ) { p0_transpose_item(a.w_xk, DM, DM, a.WXKV, 0, scr, r, lane); continue; } r -= I_SQ;
        if (r < I_SQ) { p0_transpose_item(a.w_xv, DM, DM, a.WXKV, DM, scr, r, lane); continue; } r -= I_SQ;
        if (r < I_SQ) { p0_transpose_item(a.w_xo, DM, DM, a.WXO, 0, scr, r, lane); continue; } r -= I_SQ;
        p0_transpose_item(a.w_pq, DM, 2048, a.WPQ, 0, scr, r, lane);
    }
    for (int m = gw; m < T; m += NGW) ln_row_to_bf16(a.x + (size_t)m * DM, a.ln_g, a.ln_b, a.H0 + (size_t)m * DM, lane);
    cvt_f32_bf16(a.mem, a.MEMB, (size_t)TMEM * DM, gw, NGW, lane);
    cvt_f32_bf16(a.sub_keys, a.SKB, (size_t)16 * 128 * 128, gw, NGW, lane);
    for (int it = gw; it < 4 * 128 * 128 / 512; it += NGW) {
        const int e0 = it * 512 + lane * 8, i = (e0 >> 7) & 127, j = e0 & 127; const bool keep = !(i < 64 && j >= 64);
        const GAS f32x4* s = (const GAS f32x4*)(a.w_sp + e0); const f32x4 p = s[0], q = s[1];
        v4u o; o.x = pk2(p[0], p[1]); o.y = pk2(p[2], p[3]); o.z = pk2(q[0], q[1]); o.w = pk2(q[2], q[3]);
        if (!keep) o = (v4u){0u, 0u, 0u, 0u};
        *(GAS v4u*)(a.WSPM + e0) = o;
    }
    cvt_f32_bf16(a.eu, a.EU, (size_t)NEXP * DM, gw, NGW, lane);
    cvt_f32_bf16(a.ev, a.EV, (size_t)NEXP * DM, gw, NGW, lane);
}
__device__ __forceinline__ void ln_pass(const Ctx& C, const float* Z, const float* gam, const float* bet, bf16* H) {
    const int gw = C.vcu * NWAVES + C.wave, NGW = C.G * NWAVES;
    for (int m = gw; m < T; m += NGW) ln_row_to_bf16(Z + (size_t)m * DM, gam, bet, H + (size_t)m * DM, C.lane);
}

__device__ __forceinline__ void chunk_attn_unit(const Ctx& C, const bf16* PROJ, bf16* MIXIN, const float* rel_bias, int b, int h, int cp) {
    LAS unsigned char* lds = C.lds;
    LAS float* rb = (LAS float*)(lds + 18432);
    const int lane = C.lane, w = C.wave, g = lane >> 4, li = lane & 15;
    __syncthreads();
    for (int i = C.tid; i < 257; i += NTHREADS) rb[i] = rel_bias[h * 257 + i] * LOG2E;
    const int c = 2 * cp + (w >> 2), qt = w & 3, qi = 16 * qt + li;
    const size_t tok = (size_t)b * SEQ + 64 * c + qi;
    bf16x8 qf[2];
#pragma unroll
    for (int ks = 0; ks < 2; ++ks) qf[ks] = *(const GAS bf16x8*)(PROJ + tok * NIN + 1024 + h * 64 + 32 * ks + 8 * g);
    float m = -1e30f, l = 0.f; f32x4 O[4];
#pragma unroll
    for (int dt = 0; dt < 4; ++dt) O[dt] = (f32x4){0.f, 0.f, 0.f, 0.f};
    for (int kc = 2 * cp - 8; kc <= 2 * cp + 1; ++kc) {
        if (kc < 0) continue;
        __syncthreads();
        { const int row = C.tid >> 3, ch = C.tid & 7;
          const bf16* src = PROJ + ((size_t)b * SEQ + 64 * kc + row) * NIN + 1536 + h * 64 + ch * 8;
          const v4u kv = *(const GAS v4u*)src, vv = *(const GAS v4u*)(src + 512);
          *(LAS v4u*)(lds + row * 144 + ch * 16) = kv; *(LAS v4u*)(lds + 9216 + row * 144 + ch * 16) = vv; }
        __syncthreads();
        if (kc >= c - 8 && kc <= c) {
            f32x4 s[4];
#pragma unroll
            for (int mt = 0; mt < 4; ++mt) { s[mt] = (f32x4){0.f, 0.f, 0.f, 0.f};
#pragma unroll
                for (int ks = 0; ks < 2; ++ks) { const bf16x8 a = *(const LAS bf16x8*)(lds + (16 * mt + li) * 144 + (32 * ks + 8 * g) * 2); s[mt] = MFMA16(a, qf[ks], s[mt]); } }
            const int dch = c - kc;
            if (dch >= 3) { const float bc = rb[256];
#pragma unroll
                for (int mt = 0; mt < 4; ++mt) s[mt] = s[mt] + bc;
            } else {
#pragma unroll
                for (int mt = 0; mt < 4; ++mt)
#pragma unroll
                    for (int r = 0; r < 4; ++r) { const int kj = 16 * mt + 4 * g + r; int dist = 64 * dch + qi - kj; dist = dist > 128 ? 128 : dist; s[mt][r] += rb[dist + 128]; }
            }
            float mx = -1e30f;
#pragma unroll
            for (int mt = 0; mt < 4; ++mt) mx = fmaxf(mx, fmaxf(fmaxf(s[mt][0], s[mt][1]), fmaxf(s[mt][2], s[mt][3])));
            mx = fmaxf(mx, __shfl_xor(mx, 16)); mx = fmaxf(mx, __shfl_xor(mx, 32));
            const float mn = fmaxf(m, mx), alpha = __builtin_amdgcn_exp2f(m - mn); m = mn;
            float rs = 0.f;
#pragma unroll
            for (int mt = 0; mt < 4; ++mt)
#pragma unroll
                for (int r = 0; r < 4; ++r) { s[mt][r] = __builtin_amdgcn_exp2f(s[mt][r] - mn); rs += s[mt][r]; }
            rs += __shfl_xor(rs, 16); rs += __shfl_xor(rs, 32);
            l = l * alpha + rs;
#pragma unroll
            for (int dt = 0; dt < 4; ++dt) O[dt] = O[dt] * alpha;
            bf16x8 pf[2]; pf[0] = pack8(s[0], s[1]); pf[1] = pack8(s[2], s[3]);
#pragma unroll
            for (int dt = 0; dt < 4; ++dt)
#pragma unroll
                for (int kk = 0; kk < 2; ++kk) {
                    LAS unsigned char* p = lds + 9216 + (32 * kk + 4 * g + (li >> 2)) * 144 + (16 * dt + 4 * (li & 3)) * 2;
                    const s16x4 lo = tr4(p), hi = tr4(p + 16 * 144);
                    O[dt] = MFMA16(cat8(lo, hi), pf[kk], O[dt]);
                }
        }
    }
    const float il = 1.f / l;
#pragma unroll
    for (int dt = 0; dt < 4; ++dt) { const f32x4 o = O[dt] * il; u32x2v wv; wv.x = pg8::cvt_pk_bf16(o[0], o[1]); wv.y = pg8::cvt_pk_bf16(o[2], o[3]);
        *(GAS u32x2v*)(MIXIN + tok * DM + 512 + 64 * h + 16 * dt + 4 * g) = wv; }
}
__device__ __forceinline__ void gmlp_unit(const Ctx& C, const bf16* PROJ, bf16* MIXIN, const bf16* WSPM, const float* b_sp, const float* gln_g, const float* gln_b, int blk, int grp) {
    LAS unsigned char* lds = C.lds; constexpr int WOFF = 34816;
    const int lane = C.lane, w = C.wave, g = lane >> 4, li = lane & 15;
    __syncthreads();
#pragma unroll
    for (int i = 0; i < 4; ++i) { const int ch = C.tid + NTHREADS * i, row = ch >> 4, cc = ch & 15;
        *(LAS v4u*)(lds + WOFF + row * 272 + cc * 16) = *(const GAS v4u*)(WSPM + grp * 16384 + row * 128 + cc * 8); }
    f32x4 gg0, gg1, bb0, bb1;
    { const GAS f32x4* gp = (const GAS f32x4*)(gln_g + lane * 8); gg0 = gp[0]; gg1 = gp[1]; const GAS f32x4* bp = (const GAS f32x4*)(gln_b + lane * 8); bb0 = bp[0]; bb1 = bp[1]; }
    for (int rr = 0; rr < 16; ++rr) {
        const int row = 16 * w + rr;
        const v4u raw = *(const GAS v4u*)(PROJ + ((size_t)blk * 128 + row) * NIN + 512 + lane * 8);
        f32x4 v0 = {bf_lo(raw.x), bf_hi(raw.x), bf_lo(raw.y), bf_hi(raw.y)}, v1 = {bf_lo(raw.z), bf_hi(raw.z), bf_lo(raw.w), bf_hi(raw.w)};
        const float mean = wave_sum((v0[0] + v0[1]) + (v0[2] + v0[3]) + (v1[0] + v1[1]) + (v1[2] + v1[3])) * (1.f / 512.f);
        v0 = v0 - mean; v1 = v1 - mean;
        const float var = wave_sum((v0[0] * v0[0] + v0[1] * v0[1]) + (v0[2] * v0[2] + v0[3] * v0[3]) + (v1[0] * v1[0] + v1[1] * v1[1]) + (v1[2] * v1[2] + v1[3] * v1[3])) * (1.f / 512.f);
        const float rstd = 1.f / sqrtf(var + LN_EPS);
        if (g == grp) { const f32x4 y0 = v0 * rstd * gg0 + bb0, y1 = v1 * rstd * gg1 + bb1; *(LAS bf16x8*)(lds + row * 272 + li * 16) = pack8(y0, y1); }
    }
    __syncthreads();
    f32x4 acc[8];
#pragma unroll
    for (int mt = 0; mt < 8; ++mt) acc[mt] = (f32x4){0.f, 0.f, 0.f, 0.f};
    const int nks = (w < 4) ? 2 : 4;
    for (int ks = 0; ks < nks; ++ks) {
        const bf16x8 bw = *(const LAS bf16x8*)(lds + WOFF + (16 * w + li) * 272 + (32 * ks + 8 * g) * 2);
#pragma unroll
        for (int mt = 0; mt < 8; ++mt) {
            LAS unsigned char* p = lds + (32 * ks + 8 * g + (li >> 2)) * 272 + (16 * mt + 4 * (li & 3)) * 2;
            const s16x4 lo = tr4(p), hi = tr4(p + 4 * 272);
            acc[mt] = MFMA16(cat8(lo, hi), bw, acc[mt]);
        }
    }
    const int i = 16 * w + li; const size_t row = (size_t)blk * 128 + i; const float bias = b_sp[grp * 128 + i];
#pragma unroll
    for (int mt = 0; mt < 8; ++mt) { const int c0 = 128 * grp + 16 * mt + 4 * g;
        const u32x2v ur = *(const GAS u32x2v*)(PROJ + row * NIN + c0);
        const f32x4 sv = acc[mt] + bias;
        u32x2v wv; wv.x = pg8::cvt_pk_bf16(bf_lo(ur.x) * sv[0], bf_hi(ur.x) * sv[1]); wv.y = pg8::cvt_pk_bf16(bf_lo(ur.y) * sv[2], bf_hi(ur.y) * sv[3]);
        *(GAS u32x2v*)(MIXIN + row * DM + c0) = wv; }
}

__device__ __forceinline__ void xattn_unit(const Ctx& C, const bf16* XQ, const bf16* XKV, bf16* XO, int b, int xh, int qt8) {
    LAS unsigned char* lds = C.lds;
    const int lane = C.lane, w = C.wave, g = lane >> 4, li = lane & 15;
    const size_t tok = (size_t)b * SEQ + 128 * qt8 + 16 * w + li;
    bf16x8 qf[8];
#pragma unroll
    for (int ks = 0; ks < 8; ++ks) qf[ks] = *(const GAS bf16x8*)(XQ + tok * DM + 256 * xh + 32 * ks + 8 * g);
    __syncthreads();
    {   v4u t[16];
#pragma unroll
        for (int i = 0; i < 16; ++i) { const int ch = C.tid + NTHREADS * i, row = ch >> 5, cc = ch & 31; t[i] = *(const GAS v4u*)(XKV + ((size_t)b * MEMLEN + row) * 2048 + 256 * xh + cc * 8); }
#pragma unroll
        for (int i = 0; i < 16; ++i) { const int ch = C.tid + NTHREADS * i, row = ch >> 5, cc = ch & 31; *(LAS v4u*)(lds + row * 544 + cc * 16) = t[i]; } }
    __syncthreads();
    f32x4 s[16];
#pragma unroll
    for (int mt = 0; mt < 16; ++mt) { s[mt] = (f32x4){0.f, 0.f, 0.f, 0.f};
#pragma unroll
        for (int ks = 0; ks < 8; ++ks) { const bf16x8 a = *(const LAS bf16x8*)(lds + (16 * mt + li) * 544 + (32 * ks + 8 * g) * 2); s[mt] = MFMA16(a, qf[ks], s[mt]); } }
    float mx = -1e30f;
#pragma unroll
    for (int mt = 0; mt < 16; ++mt) mx = fmaxf(mx, fmaxf(fmaxf(s[mt][0], s[mt][1]), fmaxf(s[mt][2], s[mt][3])));
    mx = fmaxf(mx, __shfl_xor(mx, 16)); mx = fmaxf(mx, __shfl_xor(mx, 32));
    float rs = 0.f;
#pragma unroll
    for (int mt = 0; mt < 16; ++mt)
#pragma unroll
        for (int r = 0; r < 4; ++r) { s[mt][r] = __builtin_amdgcn_exp2f(s[mt][r] - mx); rs += s[mt][r]; }
    rs += __shfl_xor(rs, 16); rs += __shfl_xor(rs, 32);
    const float il = 1.f / rs;
    bf16x8 pf[8];
#pragma unroll
    for (int kk = 0; kk < 8; ++kk) pf[kk] = pack8(s[2 * kk], s[2 * kk + 1]);
    __syncthreads();
    {   v4u t[16];
#pragma unroll
        for (int i = 0; i < 16; ++i) { const int ch = C.tid + NTHREADS * i, row = ch >> 5, cc = ch & 31; t[i] = *(const GAS v4u*)(XKV + ((size_t)b * MEMLEN + row) * 2048 + 1024 + 256 * xh + cc * 8); }
#pragma unroll
        for (int i = 0; i < 16; ++i) { const int ch = C.tid + NTHREADS * i, row = ch >> 5, cc = ch & 31; *(LAS v4u*)(lds + row * 544 + cc * 16) = t[i]; } }
    __syncthreads();
#pragma unroll 4
    for (int dt = 0; dt < 16; ++dt) {
        f32x4 o = {0.f, 0.f, 0.f, 0.f};
#pragma unroll
        for (int kk = 0; kk < 8; ++kk) {
            LAS unsigned char* p = lds + (32 * kk + 4 * g + (li >> 2)) * 544 + (16 * dt + 4 * (li & 3)) * 2;
            const s16x4 lo = tr4(p), hi = tr4(p + 16 * 544);
            o = MFMA16(cat8(lo, hi), pf[kk], o);
        }
        o = o * il; u32x2v wv; wv.x = pg8::cvt_pk_bf16(o[0], o[1]); wv.y = pg8::cvt_pk_bf16(o[2], o[3]);
        *(GAS u32x2v*)(XO + tok * DM + 256 * xh + 16 * dt + 4 * g) = wv;
    }
}

__device__ __forceinline__ unsigned ord_key(float x) { const unsigned u = __float_as_uint(x); return u ^ ((unsigned)((int)u >> 31) | 0x80000000u); }
__device__ __forceinline__ float ord_val(unsigned k) { return __uint_as_float(k ^ ((k & 0x80000000u) ? 0x80000000u : 0xffffffffu)); }
#define CEX_DESC(a, b) do { const unsigned _h = (a) > (b) ? (a) : (b), _l = (a) > (b) ? (b) : (a); (a) = _h; (b) = _l; } while (0)
template <int N> __device__ __forceinline__ void bitonic_sort_desc(unsigned (&v)[N]) {
#pragma unroll
    for (int k = 2; k <= N; k <<= 1)
#pragma unroll
        for (int j = k >> 1; j > 0; j >>= 1)
#pragma unroll
            for (int i = 0; i < N; ++i) { const int p = i ^ j; if (p > i) { if ((i & k) == 0) CEX_DESC(v[i], v[p]); else CEX_DESC(v[p], v[i]); } }
}
__device__ __forceinline__ void bitonic_merge16_desc(unsigned (&v)[16]) {
#pragma unroll
    for (int j = 8; j > 0; j >>= 1)
#pragma unroll
        for (int i = 0; i < 16; ++i) { const int p = i ^ j; if (p > i) CEX_DESC(v[i], v[p]); }
}
__device__ __forceinline__ void merge_xor(unsigned (&L)[16], int d) {
    unsigned o[16];
#pragma unroll
    for (int i = 0; i < 16; ++i) o[i] = (unsigned)__shfl_xor((int)L[i], d);
#pragma unroll
    for (int i = 0; i < 16; ++i) L[i] = L[i] > o[15 - i] ? L[i] : o[15 - i];
    bitonic_merge16_desc(L);
}
__host__ __device__ constexpr int cand_code(int n) {
    int cnt = 0;
    for (int i = 0; i < 16; ++i) for (int j = 0; j < 16; ++j) if ((i + 1) * (j + 1) <= 16) { if (cnt == n) return (i << 4) | j; ++cnt; }
    return -1;
}
template <int CODE> __device__ __forceinline__ unsigned cand_mk(const float (&va)[16], const float (&vb)[16]) {
    if constexpr (CODE >= 0) { const float sm = va[(CODE >> 4) & 15] + vb[CODE & 15]; return (ord_key(sm) & ~255u) | (unsigned)CODE; } else return 0u;
}
template <int TT> __device__ __forceinline__ unsigned cand_key(const float (&va)[16], const float (&vb)[16], int g) {
    const unsigned k0 = cand_mk<cand_code(TT)>(va, vb), k1 = cand_mk<cand_code(16 + TT)>(va, vb), k2 = cand_mk<cand_code(32 + TT)>(va, vb), k3 = cand_mk<cand_code(48 + TT)>(va, vb);
    return g == 0 ? k0 : (g == 1 ? k1 : (g == 2 ? k2 : k3));
}
__device__ __forceinline__ void route_unit(const Ctx& C, const bf16* PQ, const bf16* SKB, unsigned short* RIDX, float* RGATE, int tile, int h, float* dbg) {
    LAS unsigned char* lds = C.lds;
    const int lane = C.lane, w = C.wave, g = lane >> 4, li = lane & 15;
    __syncthreads();
#pragma unroll
    for (int i = 0; i < 8; ++i) { const int ch = C.tid + NTHREADS * i, p = ch >> 11, row = (ch >> 4) & 127, cc = ch & 15;
        *(LAS v4u*)(lds + p * 34816 + row * 272 + cc * 16) = *(const GAS v4u*)(SKB + ((size_t)(2 * h + p) * 128 + row) * 128 + cc * 8); }
    __syncthreads();
    const size_t tok = (size_t)tile * 128 + 16 * w + li;
    unsigned La[16], Lb[16];
#pragma unroll
    for (int p = 0; p < 2; ++p) {
        bf16x8 qf[4];
#pragma unroll
        for (int ks = 0; ks < 4; ++ks) qf[ks] = *(const GAS bf16x8*)(PQ + tok * 2048 + 256 * h + 128 * p + 32 * ks + 8 * g);
        unsigned key[32];
#pragma unroll
        for (int mt = 0; mt < 8; ++mt) { f32x4 sc = {0.f, 0.f, 0.f, 0.f};
#pragma unroll
            for (int ks = 0; ks < 4; ++ks) { const bf16x8 a = *(const LAS bf16x8*)(lds + p * 34816 + (16 * mt + li) * 272 + (32 * ks + 8 * g) * 2); sc = MFMA16(a, qf[ks], sc); }
#pragma unroll
            for (int r = 0; r < 4; ++r) key[4 * mt + r] = (ord_key(sc[r]) & ~127u) | (unsigned)(16 * mt + 4 * g + r); }
        bitonic_sort_desc<32>(key);
        unsigned L[16];
#pragma unroll
        for (int i = 0; i < 16; ++i) L[i] = key[i];
        merge_xor(L, 16); merge_xor(L, 32);
#pragma unroll
        for (int i = 0; i < 16; ++i) { if (p == 0) La[i] = L[i]; else Lb[i] = L[i]; }
    }
#if DBG_STAT == 10
    if (g == 0) {
        float best = -1e30f; int bi = -1;
        for (int k = 0; k < 128; ++k) { float a = 0.f;
            for (int d = 0; d < 128; ++d) a += bf_lo((unsigned)PQ[tok * 2048 + 256 * h + d]) * bf_lo((unsigned)SKB[((size_t)(2 * h) * 128 + k) * 128 + d]);
            if (a > best) { best = a; bi = k; } }
        if (bi != (int)(La[0] & 127u)) atomicAdd(dbg, 1.f / (float)(T * 8));
    }
#endif
    float va[16], vb[16];
#pragma unroll
    for (int i = 0; i < 16; ++i) { va[i] = ord_val(La[i] & ~127u); vb[i] = ord_val(Lb[i] & ~127u); }
    unsigned F[16];
#define CANDT(t) F[t] = cand_key<t>(va, vb, g);
    CANDT(0) CANDT(1) CANDT(2) CANDT(3) CANDT(4) CANDT(5) CANDT(6) CANDT(7) CANDT(8) CANDT(9) CANDT(10) CANDT(11) CANDT(12) CANDT(13) CANDT(14) CANDT(15)
#undef CANDT
    bitonic_sort_desc<16>(F);
    merge_xor(F, 16); merge_xor(F, 32);
    unsigned da = La[0] & 127u, db = Lb[0] & 127u;
#pragma unroll
    for (int n = 1; n < 16; ++n) { da = li == n ? (La[n] & 127u) : da; db = li == n ? (Lb[n] & 127u) : db; }
    float gv[16], gs = 0.f; const float g0 = ord_val(F[0] & ~255u);
#pragma unroll
    for (int k = 0; k < 16; ++k) { gv[k] = __builtin_amdgcn_exp2f((ord_val(F[k] & ~255u) - g0) * LOG2E); gs += gv[k]; }
    const float ig = 1.f / gs;
#pragma unroll
    for (int k = 0; k < 16; ++k) {
        const int ci = (F[k] >> 4) & 15, cj = F[k] & 15;
        int i1 = 0, i2 = 0;
#pragma unroll
        for (int n = 0; n < 16; ++n) { i1 = ci == n ? (int)(La[n] & 127u) : i1; i2 = cj == n ? (int)(Lb[n] & 127u) : i2; }
        if (g == 0) { RIDX[tok * 128 + 16 * h + k] = (unsigned short)(i1 * 128 + i2); RGATE[tok * 128 + 16 * h + k] = gv[k] * ig; }
#if DBG_STAT == 12
        if (k == 0 && g == 0 && (i1 * 128 + i2) != (int)((La[0] & 127u) * 128u + (Lb[0] & 127u))) atomicAdd(dbg, 1.f / (float)(T * 8));
        if (k == 1 && g == 0) { const int e01 = (int)((La[0] & 127u) * 128u + (Lb[1] & 127u)), e10 = (int)((La[1] & 127u) * 128u + (Lb[0] & 127u)); if ((i1 * 128 + i2) != e01 && (i1 * 128 + i2) != e10) atomicAdd(dbg, 1.f / (float)(T * 8)); }
#endif
    }
}

__device__ __forceinline__ float dot2u(unsigned a, unsigned b, float acc) {
    return __builtin_amdgcn_fdot2_f32_bf16(__builtin_bit_cast(v2bf16, a), __builtin_bit_cast(v2bf16, b), acc, false);
}
__device__ __forceinline__ float dot8(v4u a, v4u b, float acc) {
    const unsigned a0 = a.x, a1 = a.y, a2 = a.z, a3 = a.w, b0 = b.x, b1 = b.y, b2 = b.z, b3 = b.w;
    acc = dot2u(a0, b0, acc); acc = dot2u(a1, b1, acc); acc = dot2u(a2, b2, acc); acc = dot2u(a3, b3, acc);
    return acc;
}
__device__ __forceinline__ void axpy8(float (&o)[8], float a, v4u v) {
    o[0] += a * bf_lo(v.x); o[1] += a * bf_hi(v.x); o[2] += a * bf_lo(v.y); o[3] += a * bf_hi(v.y);
    o[4] += a * bf_lo(v.z); o[5] += a * bf_hi(v.z); o[6] += a * bf_lo(v.w); o[7] += a * bf_hi(v.w);
}
__device__ __forceinline__ void expert_phase(const Ctx& C, const bf16* H2, const bf16* EU, const bf16* EV, const unsigned short* RIDX, const float* RGATE,
                                             const float* g3, const float* b3, float* out, float* dbg) {
    const int lane = C.lane;
    const int gw = C.vcu * NWAVES + C.wave, NGW = C.G * NWAVES;
    for (int tok = gw; tok < T; tok += NGW) {
        const v4u x0 = *(const GAS v4u*)(H2 + (size_t)tok * DM + lane * 8), x1 = *(const GAS v4u*)(H2 + (size_t)tok * DM + 512 + lane * 8);
        const int e_lo = RIDX[(size_t)tok * 128 + lane], e_hi = RIDX[(size_t)tok * 128 + 64 + lane];
        const float g_lo = RGATE[(size_t)tok * 128 + lane], g_hi = RGATE[(size_t)tok * 128 + 64 + lane];
        float oa[8], ob[8]; float zsq = 0.f; (void)zsq;
#pragma unroll
        for (int i = 0; i < 8; ++i) { oa[i] = 0.f; ob[i] = 0.f; }
        for (int b8 = 0; b8 < ((DBG_MASK & 4) ? 0 : 8); ++b8) {
            const int ev = b8 < 4 ? e_lo : e_hi; const float gvv = b8 < 4 ? g_lo : g_hi; const int lb = 16 * (b8 & 3);
            float d[16];
#pragma unroll
            for (int sub = 0; sub < 2; ++sub) {
                v4u ua[8], ub[8];
#pragma unroll
                for (int kk = 0; kk < 8; ++kk) { const int e = __builtin_amdgcn_readlane(ev, lb + 8 * sub + kk); const bf16* up = EU + (size_t)e * DM + lane * 8;
                    ua[kk] = *(const GAS v4u*)up; ub[kk] = *(const GAS v4u*)(up + 512); }
#pragma unroll
                for (int kk = 0; kk < 8; ++kk) d[8 * sub + kk] = dot8(ub[kk], x1, dot8(ua[kk], x0, 0.f));
            }
            float r8[8], r4[4], r2[2], r1;
            { const bool hi = (lane & 32) != 0;
#pragma unroll
              for (int i = 0; i < 8; ++i) { const float keep = hi ? d[i + 8] : d[i], send = hi ? d[i] : d[i + 8]; r8[i] = keep + __shfl_xor(send, 32); } }
            { const bool hi = (lane & 16) != 0;
#pragma unroll
              for (int i = 0; i < 4; ++i) { const float keep = hi ? r8[i + 4] : r8[i], send = hi ? r8[i] : r8[i + 4]; r4[i] = keep + __shfl_xor(send, 16); } }
            { const bool hi = (lane & 8) != 0;
#pragma unroll
              for (int i = 0; i < 2; ++i) { const float keep = hi ? r4[i + 2] : r4[i], send = hi ? r4[i] : r4[i + 2]; r2[i] = keep + __shfl_xor(send, 8); } }
            { const bool hi = (lane & 4) != 0; const float keep = hi ? r2[1] : r2[0], send = hi ? r2[0] : r2[1]; r1 = keep + __shfl_xor(send, 4); }
            r1 += __shfl_xor(r1, 2); r1 += __shfl_xor(r1, 1);
            const float gate = __shfl(gvv, lb + ((lane >> 2) & 15));
#if DBG_STAT == 11
            if (b8 == 3) { const int e0 = RIDX[(size_t)tok * 128 + 48 + 5]; float zr = 0.f;
                for (int c = 0; c < 16; ++c) zr += bf_lo((unsigned)EU[(size_t)e0 * DM + lane * 16 + c]) * bf_lo((unsigned)H2[(size_t)tok * DM + lane * 16 + c]);
                zr = wave_sum(zr); const float mine = __shfl(r1, 20);
                if (lane == 0 && fabsf(zr - mine) > 0.02f * (1.f + fabsf(zr))) atomicAdd(dbg, 1.f / (float)T); }
#endif
            const float av = gate * pg8::gelu1(r1);
#if DBG_STAT
            zsq += wave_sum(r1 * r1);
#endif
#pragma unroll
            for (int sub = 0; sub < 2; ++sub) {
                v4u wa[8], wb[8];
#pragma unroll
                for (int kk = 0; kk < 8; ++kk) { const int e = __builtin_amdgcn_readlane(ev, lb + 8 * sub + kk); const bf16* vp = EV + (size_t)e * DM + lane * 8;
                    wa[kk] = *(const GAS v4u*)vp; wb[kk] = *(const GAS v4u*)(vp + 512); }
#pragma unroll
                for (int kk = 0; kk < 8; ++kk) { const float ak = __uint_as_float(__builtin_amdgcn_readlane(__float_as_uint(av), 4 * (8 * sub + kk))); axpy8(oa, ak, wa[kk]); axpy8(ob, ak, wb[kk]); }
            }
        }
#if DBG_STAT
        { float q = 0.f;
#pragma unroll
          for (int i = 0; i < 8; ++i) { q += oa[i] * oa[i] + ob[i] * ob[i]; }
          q = wave_sum(q) * (1.f / (float)DM);
          if (DBG_STAT == 2) q = zsq * (1.f / 512.f);
          if (DBG_STAT == 3) q = wave_sum(g_lo * g_lo + g_hi * g_hi);
          if (DBG_STAT == 4) q = wave_sum(g_lo + g_hi) * 0.125f;
          if (DBG_STAT >= 10) q = 0.f;
          if (lane == 0) atomicAdd(dbg, q * (1.f / (float)T));
#pragma unroll
          for (int i = 0; i < 8; ++i) { oa[i] = 0.f; ob[i] = 0.f; } }
#endif
        float za[8], zb[8];
        za[0] = DN_ALPHA * bf_lo(x0.x) + oa[0]; za[1] = DN_ALPHA * bf_hi(x0.x) + oa[1]; za[2] = DN_ALPHA * bf_lo(x0.y) + oa[2]; za[3] = DN_ALPHA * bf_hi(x0.y) + oa[3];
        za[4] = DN_ALPHA * bf_lo(x0.z) + oa[4]; za[5] = DN_ALPHA * bf_hi(x0.z) + oa[5]; za[6] = DN_ALPHA * bf_lo(x0.w) + oa[6]; za[7] = DN_ALPHA * bf_hi(x0.w) + oa[7];
        zb[0] = DN_ALPHA * bf_lo(x1.x) + ob[0]; zb[1] = DN_ALPHA * bf_hi(x1.x) + ob[1]; zb[2] = DN_ALPHA * bf_lo(x1.y) + ob[2]; zb[3] = DN_ALPHA * bf_hi(x1.y) + ob[3];
        zb[4] = DN_ALPHA * bf_lo(x1.z) + ob[4]; zb[5] = DN_ALPHA * bf_hi(x1.z) + ob[5]; zb[6] = DN_ALPHA * bf_lo(x1.w) + ob[6]; zb[7] = DN_ALPHA * bf_hi(x1.w) + ob[7];
        float s = 0.f;
#pragma unroll
        for (int i = 0; i < 8; ++i) s += za[i] + zb[i];
        const float mean = wave_sum(s) * (1.f / DM); float s2 = 0.f;
#pragma unroll
        for (int i = 0; i < 8; ++i) { za[i] -= mean; zb[i] -= mean; s2 += za[i] * za[i] + zb[i] * zb[i]; }
        const float rstd = 1.f / sqrtf(wave_sum(s2) * (1.f / DM) + LN_EPS);
        const GAS f32x4* gp = (const GAS f32x4*)(g3 + lane * 8); const GAS f32x4* bp = (const GAS f32x4*)(b3 + lane * 8);
        const f32x4 ga0 = gp[0], ga1 = gp[1], gb0 = gp[128], gb1 = gp[129], ba0 = bp[0], ba1 = bp[1], bb0 = bp[128], bb1 = bp[129];
        GAS f32x4* op = (GAS f32x4*)(out + (size_t)tok * DM + lane * 8);
        op[0] = (f32x4){za[0], za[1], za[2], za[3]} * rstd * ga0 + ba0; op[1] = (f32x4){za[4], za[5], za[6], za[7]} * rstd * ga1 + ba1;
        op[128] = (f32x4){zb[0], zb[1], zb[2], zb[3]} * rstd * gb0 + bb0; op[129] = (f32x4){zb[4], zb[5], zb[6], zb[7]} * rstd * gb1 + bb1;
    }
}

constexpr int NPHASES = 12 + (DBG_STAT ? 1 : 0);
struct Args { const float* in[25]; float* out; unsigned char* ws; int ph_lo, ph_hi, li, pad; };
__global__ void __launch_bounds__(NTHREADS, 2) fwd_kernel(Args args) {
    extern __shared__ __attribute__((aligned(16))) unsigned char lds_raw[];
    Ctx C;
    C.lds = (LAS unsigned char*)lds_raw;
    C.tid = threadIdx.x; C.lane = C.tid & 63; C.wave = __builtin_amdgcn_readfirstlane(C.tid >> 6);
    C.G = gridDim.x; { const int bx = blockIdx.x; C.vcu = (C.G % 8 == 0) ? (bx % 8) * (C.G / 8) + bx / 8 : bx; }
    volatile LAS unsigned* MISC = (volatile LAS unsigned*)(C.lds + LDSCTL_OFF);
    unsigned char* ws = args.ws;
    gu32* ctl = (gu32*)(ws + WS_CTL);
    for (int u = C.tid; u < (LDS_BYTES - LDSCTL_OFF) / 4; u += NTHREADS) ((LAS unsigned*)(C.lds + LDSCTL_OFF))[u] = 0u;
    __syncthreads();
    const int lo = args.ph_lo, hi = args.ph_hi;
    const bool multi = (hi - lo) > 1;
    XcdBarrier bar; bar.bar = (unsigned*)(ctl + CW_BAR) + args.li * XCD_BAR_WORDS; bar.x = 0; bar.st = nullptr;
    if (multi) bar = xcd_barrier_post((unsigned*)(ctl + CW_BAR) + args.li * XCD_BAR_WORDS, MISC + 8);
#define IN(k) (lo <= (k) && (k) < hi)
#define SEAM(k) do { if (IN(k) && IN((k) + 1)) xcd_barrier(bar); } while (0)

    const float* x = args.in[0]; const float* mem = args.in[1]; const float* ln_in_g = args.in[2]; const float* ln_in_b = args.in[3]; const float* w_in = args.in[4];
    const float* gate_ln_g = args.in[5]; const float* gate_ln_b = args.in[6]; const float* w_sp = args.in[7]; const float* b_sp = args.in[8]; const float* rel_bias = args.in[9];
    const float* w_out = args.in[10]; const float* ln1_g = args.in[11]; const float* ln1_b = args.in[12]; const float* w_xq = args.in[13]; const float* w_xk = args.in[14];
    const float* w_xv = args.in[15]; const float* w_xo = args.in[16]; const float* ln2_g = args.in[17]; const float* ln2_b = args.in[18]; const float* w_pq = args.in[19];
    const float* sub_keys = args.in[20]; const float* expert_u = args.in[21]; const float* expert_v = args.in[22]; const float* ln3_g = args.in[23]; const float* ln3_b = args.in[24];
    bf16* WIN = (bf16*)(ws + WS_WIN); bf16* WOUT = (bf16*)(ws + WS_WOUT); bf16* WXQ = (bf16*)(ws + WS_WXQ); bf16* WXKV = (bf16*)(ws + WS_WXKV); bf16* WXO = (bf16*)(ws + WS_WXO);
    bf16* WPQ = (bf16*)(ws + WS_WPQ); bf16* SKB = (bf16*)(ws + WS_SKB); bf16* WSPM = (bf16*)(ws + WS_WSPM); bf16* EU = (bf16*)(ws + WS_EU); bf16* EV = (bf16*)(ws + WS_EV);
    bf16* PROJ = (bf16*)(ws + WS_PROJ); bf16* XQ = (bf16*)(ws + WS_XQ); bf16* XO = (bf16*)(ws + WS_XO); bf16* PQ = (bf16*)(ws + WS_PQ);
    bf16* H0 = (bf16*)(ws + WS_B); bf16* H2 = (bf16*)(ws + WS_B); bf16* MIXIN = (bf16*)(ws + WS_C); bf16* H1 = (bf16*)(ws + WS_C);
    bf16* MEMB = (bf16*)(ws + WS_MEMB); bf16* XKV = (bf16*)(ws + WS_XKV); unsigned short* RIDX = (unsigned short*)(ws + WS_RIDX); float* RGATE = (float*)(ws + WS_RGATE);
    float* Z = args.out;

    if (IN(0)) {
        P0Args a{x, mem, ln_in_g, ln_in_b, w_in, w_sp, w_out, w_xq, w_xk, w_xv, w_xo, w_pq, sub_keys, expert_u, expert_v, WIN, WOUT, WXQ, WXKV, WXO, WPQ, SKB, WSPM, EU, EV, H0, MEMB};
        p0_prologue(C, a);
    }
    SEAM(0);
    if (IN(1)) {
        pg8::Gemm2 g{H0, WIN, MEMB, WXKV, DM}; pg8::Order2 S; S.init(T, NIN, TMEM, 2048, C.G, (int)blockIdx.x);
        pg8::EpiProj E{PROJ, NIN, XKV, 2048, QB_SCALE, 1024, 1536};
        pg8::gemm_phase<pg8::EpiProj, pg8::Order2, true, true>(C.lds, g, S, E);
    }
    SEAM(1);
    if (IN(2)) {
        for (int v = C.vcu; v < 1536; v += C.G) {
            if (v < 1024) chunk_attn_unit(C, PROJ, MIXIN, rel_bias, v >> 7, (v >> 4) & 7, v & 15);
            else { const int u = v - 1024; gmlp_unit(C, PROJ, MIXIN, WSPM, b_sp, gate_ln_g, gate_ln_b, u >> 2, u & 3); }
        }
    }
    SEAM(2);
    if (IN(3)) {
        pg8::Gemm2 g{MIXIN, WOUT, MIXIN, WOUT, DM}; pg8::Order2 S; S.init(T, DM, 0, 256, C.G, (int)blockIdx.x);
        pg8::EpiZ E{H0, Z, DM, DN_ALPHA, (DBG_MASK & 1) ? 0.f : 1.f};
        pg8::gemm_phase<pg8::EpiZ, pg8::Order2, true, true>(C.lds, g, S, E);
    }
    SEAM(3);
    if (IN(4)) ln_pass(C, Z, ln1_g, ln1_b, H1);
    SEAM(4);
    if (IN(5)) {
        pg8::Gemm2 g{H1, WXQ, H1, WXQ, DM}; pg8::Order2 S; S.init(T, DM, 0, 256, C.G, (int)blockIdx.x);
        pg8::EpiProj E{XQ, DM, XQ, DM, XQ_SCALE, 0, 1 << 30};
        pg8::gemm_phase<pg8::EpiProj, pg8::Order2, true, true>(C.lds, g, S, E);
    }
    SEAM(5);
    if (IN(6)) {
        for (int v = C.vcu; v < 512; v += C.G) xattn_unit(C, XQ, XKV, XO, v >> 6, (v >> 4) & 3, v & 15);
    }
    SEAM(6);
    if (IN(7)) {
        pg8::Gemm2 g{XO, WXO, XO, WXO, DM}; pg8::Order2 S; S.init(T, DM, 0, 256, C.G, (int)blockIdx.x);
        pg8::EpiZ E{H1, Z, DM, DN_ALPHA, (DBG_MASK & 2) ? 0.f : 1.f};
        pg8::gemm_phase<pg8::EpiZ, pg8::Order2, true, true>(C.lds, g, S, E);
    }
    SEAM(7);
    if (IN(8)) ln_pass(C, Z, ln2_g, ln2_b, H2);
    SEAM(8);
    if (IN(9)) {
        pg8::Gemm2 g{H2, WPQ, H2, WPQ, DM}; pg8::Order2 S; S.init(T, 2048, 0, 256, C.G, (int)blockIdx.x);
        pg8::EpiProj E{PQ, 2048, PQ, 2048, 1.f, 0, 0};
        pg8::gemm_phase<pg8::EpiProj, pg8::Order2, true, true>(C.lds, g, S, E);
    }
    SEAM(9);
    if (IN(10)) {
        for (int v = C.vcu; v < 1024; v += C.G) route_unit(C, PQ, SKB, RIDX, RGATE, v >> 3, v & 7, (float*)(ctl + 64));
    }
    SEAM(10);
    float* dbg = (float*)(ctl + 64);
    if (IN(11)) expert_phase(C, H2, EU, EV, RIDX, RGATE, ln3_g, ln3_b, args.out, dbg);
#if DBG_STAT
    if (IN(12)) { const float s = 1.f + 10.f * __hip_atomic_load(dbg, __ATOMIC_RELAXED, __HIP_MEMORY_SCOPE_AGENT);
        for (size_t i = (size_t)blockIdx.x * NTHREADS + C.tid; i < (size_t)T * DM; i += (size_t)C.G * NTHREADS) args.out[i] *= s; }
#endif
#undef IN
#undef SEAM
}

extern "C" void kernel_launch(void* const* d_in, const int* in_sizes, int n_in, void* d_out, int out_size, void* d_ws, size_t ws_size, hipStream_t stream) {
    static int grid = 0;
    if (grid == 0) {
        if (n_in != 25 || in_sizes[0] != T * DM || out_size != T * DM || ws_size < WS_END) {
            fprintf(stderr, "kernel_launch: unexpected problem (n_in %d, in0 %d, out %d, ws %zu); nothing launched\n", n_in, n_in > 0 ? in_sizes[0] : -1, out_size, ws_size); grid = -1; return; }
        int dev = 0, cus = 0, per_cu = 0;
        if (hipGetDevice(&dev) != hipSuccess || hipDeviceGetAttribute(&cus, hipDeviceAttributeMultiprocessorCount, dev) != hipSuccess) { grid = -1; return; }
        if (hipFuncSetAttribute((const void*)fwd_kernel, hipFuncAttributeMaxDynamicSharedMemorySize, LDS_BYTES) != hipSuccess) { fprintf(stderr, "kernel_launch: hipFuncSetAttribute failed\n"); grid = -1; return; }
        if (hipOccupancyMaxActiveBlocksPerMultiprocessor(&per_cu, (const void*)fwd_kernel, NTHREADS, LDS_BYTES) != hipSuccess || per_cu < 1)
            fprintf(stderr, "kernel_launch: note: occupancy query reports %d workgroups per CU\n", per_cu);
        (void)hipGetLastError();
        grid = cus;
    }
    if (grid < 0) return;
    if (hipMemsetAsync((char*)d_ws + WS_CTL, 0, CTL_ZERO_BYTES, stream) != hipSuccess) { fprintf(stderr, "kernel_launch: memset failed\n"); return; }
    Args a{};
    for (int i = 0; i < 25; ++i) a.in[i] = (const float*)d_in[i];
    a.out = (float*)d_out; a.ws = (unsigned char*)d_ws;
    constexpr int NL = MK_N_LAUNCHES;
    static_assert(NL == 1 || NL == 12, "MK_N_LAUNCHES: 1 (one launch) or 12 (one launch per phase)");
    for (int li = 0; li < (NL == 1 ? 1 : NPHASES); ++li) {
        a.ph_lo = (NL == 1) ? 0 : li; a.ph_hi = (NL == 1) ? NPHASES : li + 1; a.li = 0;
        hipLaunchKernelGGL(fwd_kernel, dim3(grid), dim3(NTHREADS), LDS_BYTES, stream, a);
        const hipError_t le = hipPeekAtLastError();
        if (le != hipSuccess) { fprintf(stderr, "kernel_launch: launch %d failed: %s\n", li, hipGetErrorName(le)); break; }
    }
}
```

```cpp
#include <hip/hip_runtime.h>
#include <cstdio>
#include <cstdint>

#ifndef DBG_MASK
#define DBG_MASK 0
#endif
#ifndef DBG_STAT
#define DBG_STAT 0
#endif
#ifndef DBG_REPEAT
#define DBG_REPEAT -1
#endif
#ifndef MK_N_LAUNCHES
#define MK_N_LAUNCHES 1
#endif

namespace pg8 {
#define PG8_LAS __attribute__((address_space(3)))
typedef unsigned short bf16_t;
typedef short bf16x8 __attribute__((ext_vector_type(8)));
typedef float f32x4 __attribute__((ext_vector_type(4)));
typedef unsigned u32x4 __attribute__((ext_vector_type(4)));
typedef unsigned u32x2 __attribute__((ext_vector_type(2)));
constexpr int BM = 256, BK = 64, HALF = 128, HTB = HALF * BK * 2  , STAGE_BYTES = 8 * HTB, NXCD = 8, WGM = 8;

__host__ __device__ __forceinline__ int lds_byte(int r, int c) { const int st = (r >> 4) * 2 + (c >> 5), rr = r & 15, cc = c & 31, ob = rr * 64 + cc * 2; return st * 1024 + (ob ^ (((ob >> 9) & 1) << 5)); }
__host__ __device__ __forceinline__ void stage_rc(int b, int& R, int& C) { const int st = b / 1024, sb = b % 1024, swz = sb ^ (((sb >> 9) & 1) << 5); R = (st >> 1) * 16 + swz / 64; C = (st & 1) * 32 + (swz % 64) / 2; }
__host__ __device__ __forceinline__ int perm32(int rho) { const int n = rho >> 4, i = rho & 15; return 8 * (i >> 2) + 4 * n + (i & 3); }

struct Unit { int pm, pn, g; };
struct Gemm2 { const bf16_t* A0; const bf16_t* B0; const bf16_t* A1; const bf16_t* B1; int K; };

struct Order2 {
    int nM0, nN0, nwg0, nM1, nN1, nwg1, G, c;
    __device__ void init(int M0, int N0, int M1, int N1, int G_, int c_) { nM0 = M0 / BM; nN0 = N0 / BM; nwg0 = nM0 * nN0; nM1 = M1 / BM; nN1 = N1 / BM; nwg1 = nM1 * nN1; G = G_; c = c_; }
    __device__ __forceinline__ bool next(int i, Unit& u) const {
        const int L = i * G + c; const bool in0 = L < nwg0;
        int wgid = in0 ? L : 0; { const int q = nwg0 / NXCD, r = nwg0 % NXCD, xcd = wgid % NXCD, off = wgid / NXCD; wgid = (xcd < r ? xcd * (q + 1) : r * (q + 1) + (xcd - r) * q) + off; }
        const int nig = WGM * nN0, gid = wgid / nig, fm = gid * WGM, gsz = (nM0 - fm) < WGM ? (nM0 - fm) : WGM;
        const int pm0 = fm + ((wgid % nig) % gsz), pn0 = (wgid % nig) / gsz;
        const int L1 = in0 ? 0 : L - nwg0, d1 = nM1 > 0 ? nM1 : 1;
        u.pm = in0 ? pm0 : (L1 % d1); u.pn = in0 ? pn0 : (L1 / d1); u.g = in0 ? 0 : 1;
        return in0 || (L - nwg0 < nwg1);
    }
    __device__ __forceinline__ void a_ready(const Unit&) const {}
    __device__ __forceinline__ void done(const Unit&) const {}
};

__device__ __forceinline__ unsigned cvt_pk_bf16(float lo, float hi) { unsigned r; asm volatile("v_cvt_pk_bf16_f32 %0, %1, %2" : "=v"(r) : "v"(lo), "v"(hi)); return r; }
typedef float f32x2 __attribute__((ext_vector_type(2)));
__device__ __forceinline__ f32x2 gelu_pk(f32x2 v) {
    const f32x2 av = __builtin_elementwise_abs(v), d = av * 0.2316418882f + 1.0f;
    f32x2 t; t.x = __builtin_amdgcn_rcpf(d.x); t.y = __builtin_amdgcn_rcpf(d.y);
    f32x2 q = t * 0.5307027145f + (-0.7265760135f); q = q * t + 0.7107068705f; q = q * t + (-0.142248368f); q = q * t + 0.127414796f; q = q * t;
    const f32x2 s = (v * v) * (-0.72134752044f);
    f32x2 e; e.x = __builtin_amdgcn_exp2f(s.x); e.y = __builtin_amdgcn_exp2f(s.y);
    const f32x2 m = v * (q * e), r = v - m;
    f32x2 o; o.x = v.x < 0.f ? m.x : r.x; o.y = v.y < 0.f ? m.y : r.y; return o;
}
__device__ __forceinline__ float gelu1(float v) { f32x2 x = {v, v}; return gelu_pk(x).x; }

struct EpiProj {
    static constexpr bool PERM = true, AFTER_DRAIN = false;
    bf16_t* O0; int ld0; bf16_t* O1; int ld1; float qscale; int gelu_cols, scale_cols;
    __device__ __forceinline__ void operator()(const f32x4 (&acc)[2][2][4][2], const Unit& u, int wr, int wc, int fr, int fq) const {
        const int row0 = u.pm * BM + wr * 64 + fr; const int colt = u.pn * BM;
        bf16_t* base = u.g ? O1 : O0; const int ldc = u.g ? ld1 : ld0;
        const int mode = u.g ? 0 : (colt < gelu_cols ? 1 : (colt < scale_cols ? 2 : 0));
        const float sc = mode == 2 ? qscale : 1.f;
        const int col0 = colt + wc * 32 + 8 * fq;
#pragma unroll
        for (int ai = 0; ai < 2; ++ai)
#pragma unroll
            for (int m = 0; m < 4; ++m) { bf16_t* rowp = base + (size_t)(row0 + ai * HALF + m * 16) * ldc + col0;
#pragma unroll
                for (int bj = 0; bj < 2; ++bj) { f32x4 v0 = acc[ai][bj][m][0], v1 = acc[ai][bj][m][1];
                    if (mode == 1) { f32x2 a = gelu_pk((f32x2){v0[0], v0[1]}), b = gelu_pk((f32x2){v0[2], v0[3]}), c = gelu_pk((f32x2){v1[0], v1[1]}), d = gelu_pk((f32x2){v1[2], v1[3]});
                        v0 = (f32x4){a.x, a.y, b.x, b.y}; v1 = (f32x4){c.x, c.y, d.x, d.y}; }
                    v0 = v0 * sc; v1 = v1 * sc; u32x4 w; w.x = cvt_pk_bf16(v0[0], v0[1]); w.y = cvt_pk_bf16(v0[2], v0[3]); w.z = cvt_pk_bf16(v1[0], v1[1]); w.w = cvt_pk_bf16(v1[2], v1[3]);
                    *(u32x4*)(rowp + bj * HALF) = w; } }
    }
};
struct EpiZ {
    static constexpr bool PERM = false, AFTER_DRAIN = false;
    const bf16_t* res; float* z; int ldc; float alpha; float accw;
    __device__ __forceinline__ void operator()(const f32x4 (&acc)[2][2][4][2], const Unit& u, int wr, int wc, int fr, int fq) const {
        const int col0 = u.pn * BM + wc * 32 + 4 * fq;
#pragma unroll
        for (int ai = 0; ai < 2; ++ai)
#pragma unroll
            for (int m = 0; m < 4; ++m) { const size_t off = (size_t)(u.pm * BM + ai * HALF + wr * 64 + m * 16 + fr) * ldc + col0;
#pragma unroll
                for (int bj = 0; bj < 2; ++bj)
#pragma unroll
                    for (int n = 0; n < 2; ++n) { const u32x2 rb = *(const u32x2*)(res + off + bj * HALF + n * 16);
                        f32x4 r; r[0] = __uint_as_float(rb.x << 16); r[1] = __uint_as_float(rb.x & 0xffff0000u); r[2] = __uint_as_float(rb.y << 16); r[3] = __uint_as_float(rb.y & 0xffff0000u);
                        *(f32x4*)(z + off + bj * HALF + n * 16) = r * alpha + acc[ai][bj][m][n] * accw; } }
    }
};

template <class Epi, class Sched, bool ALIGN_EPI = false, bool SP2 = false>
__device__ __forceinline__ void gemm_phase(PG8_LAS unsigned char* lds, const Gemm2 g, const Sched& S, const Epi& E) {
    const int tid = threadIdx.x, wid = __builtin_amdgcn_readfirstlane(tid >> 6), lane = tid & 63, wr = wid >> 2, wc = wid & 3, fr = lane & 15, fq = lane >> 4;
    const int K = g.K, nt = K / BK;
    unsigned voffA[2], voffB[2];
#pragma unroll
    for (int i = 0; i < 2; ++i) { int R, C; stage_rc(tid * 16 + i * 8192, R, C); const int Rb = Epi::PERM ? ((R & ~31) + perm32(R & 31)) : R;
        voffA[i] = (unsigned)(R * K + C) * 2u; voffB[i] = (unsigned)(Rb * K + C) * 2u; }
    const size_t kstep = (size_t)(BK * 2);
    const size_t hstep = (size_t)HALF * K * 2;
    const size_t tstep = 2 * hstep;
    const unsigned ldsw = (unsigned)wid * 1024u;
    const int aoff = lds_byte(wr * 64 + fr, fq * 8), boff = lds_byte(wc * 32 + fr, fq * 8);
#define PG8_SA(b, h) (((b) * 2 + (h)) * HTB)
#define PG8_SB(b, h) ((4 + (b) * 2 + (h)) * HTB)
#define PG8_STAGE(bufoff, gbase, voff) do { _Pragma("unroll") for (int _i = 0; _i < 2; ++_i) \
        __builtin_amdgcn_global_load_lds((const unsigned*)((const char*)(gbase) + (voff)[_i]), (PG8_LAS unsigned*)(lds + (bufoff) + ldsw + _i * 8192), 16, 0, 0); } while (0)
#define PG8_LDA(dst, b, h) do { _Pragma("unroll") for (int m = 0; m < 4; ++m) _Pragma("unroll") for (int k = 0; k < 2; ++k) dst[m][k] = *(const PG8_LAS bf16x8*)(lds + PG8_SA(b, h) + aoff + m * 2048 + k * 1024); } while (0)
#define PG8_LDB(dst, b, h) do { _Pragma("unroll") for (int n = 0; n < 2; ++n) _Pragma("unroll") for (int k = 0; k < 2; ++k) dst[n][k] = *(const PG8_LAS bf16x8*)(lds + PG8_SB(b, h) + boff + n * 2048 + k * 1024); } while (0)
#define PG8_MMA(ai, bj, At, Bt) do { __builtin_amdgcn_s_setprio(1); _Pragma("unroll") for (int m = 0; m < 4; ++m) _Pragma("unroll") for (int n = 0; n < 2; ++n) _Pragma("unroll") for (int k = 0; k < 2; ++k) \
        acc[ai][bj][m][n] = __builtin_amdgcn_mfma_f32_16x16x32_bf16(Bt[n][k], At[m][k], acc[ai][bj][m][n], 0, 0, 0); __builtin_amdgcn_s_setprio(0); } while (0)
#define PG8_WAIT_V(n) asm volatile("s_waitcnt vmcnt(" #n ")" ::: "memory")
#define PG8_WAIT_L(n) asm volatile("s_waitcnt lgkmcnt(" #n ")" ::: "memory")
#define PG8_BAR __builtin_amdgcn_s_barrier()
#define PG8_SCHED __builtin_amdgcn_sched_barrier(0)
    Unit cur, nxt; int ui = 0;
    if (!S.next(0, cur)) return;
    f32x4 acc[2][2][4][2];
#pragma unroll
    for (int a = 0; a < 2; ++a)
#pragma unroll
        for (int b = 0; b < 2; ++b)
#pragma unroll
            for (int m = 0; m < 4; ++m)
#pragma unroll
                for (int n = 0; n < 2; ++n) acc[a][b][m][n] = (f32x4){0.f, 0.f, 0.f, 0.f};
    bf16x8 At[4][2], B0[2][2], B1[2][2];
    const char* cA = (const char*)(cur.g ? g.A1 : g.A0) + (size_t)cur.pm * tstep; const char* cB = (const char*)(cur.g ? g.B1 : g.B0) + (size_t)cur.pn * tstep;
    S.a_ready(cur);
    if constexpr (SP2) {
        PG8_STAGE(PG8_SB(0, 0), cB, voffB); PG8_STAGE(PG8_SB(0, 1), cB + hstep, voffB); PG8_STAGE(PG8_SA(0, 0), cA, voffA); PG8_STAGE(PG8_SA(0, 1), cA + hstep, voffA);
        if (wr == 1) PG8_BAR;
        PG8_WAIT_V(2); PG8_BAR;
        PG8_STAGE(PG8_SB(1, 0), cB + kstep, voffB); PG8_STAGE(PG8_SA(1, 0), cA + kstep, voffA); PG8_STAGE(PG8_SB(1, 1), cB + hstep + kstep, voffB);
        PG8_WAIT_V(6); PG8_BAR;
    } else {
        PG8_STAGE(PG8_SB(0, 0), cB, voffB); PG8_STAGE(PG8_SA(0, 0), cA, voffA); PG8_STAGE(PG8_SB(0, 1), cB + hstep, voffB); PG8_STAGE(PG8_SA(0, 1), cA + hstep, voffA);
        if (wr == 1) PG8_BAR;
        PG8_WAIT_V(4); PG8_BAR;
        PG8_STAGE(PG8_SB(1, 0), cB + kstep, voffB); PG8_STAGE(PG8_SA(1, 0), cA + kstep, voffA); PG8_STAGE(PG8_SB(1, 1), cB + hstep + kstep, voffB);
        PG8_WAIT_V(6); PG8_BAR;
    }
    for (;;) {
        const bool has_next = S.next(ui + 1, nxt);
        const char* nA = has_next ? (const char*)(nxt.g ? g.A1 : g.A0) + (size_t)nxt.pm * tstep : cA; const char* nB = has_next ? (const char*)(nxt.g ? g.B1 : g.B0) + (size_t)nxt.pn * tstep : cB;
        for (int t = 0; t < nt; t += 2) {
            const bool last = (t == nt - 2);
            const char* a1 = cA + (size_t)(t + 1) * kstep;
            const char* a2 = last ? nA : cA + (size_t)(t + 2) * kstep; const char* b2 = last ? nB : cB + (size_t)(t + 2) * kstep;
            const char* a3 = a2 + kstep; const char* b3 = b2 + kstep;
            if (last && has_next) S.a_ready(nxt);
            if constexpr (SP2) {
            PG8_LDB(B0, 0, 0); PG8_LDB(B1, 0, 1); PG8_SCHED; PG8_LDA(At, 0, 0); PG8_STAGE(PG8_SA(1, 1), a1 + hstep, voffA);
            PG8_WAIT_V(8); PG8_WAIT_L(0); PG8_BAR; PG8_MMA(0, 0, At, B0); PG8_MMA(0, 1, At, B1); PG8_BAR; PG8_SCHED;
            PG8_LDA(At, 0, 1); PG8_STAGE(PG8_SB(0, 0), b2, voffB); PG8_STAGE(PG8_SB(0, 1), b2 + hstep, voffB); PG8_STAGE(PG8_SA(0, 0), a2, voffA);
            PG8_WAIT_V(8); PG8_WAIT_L(0); PG8_BAR; PG8_MMA(1, 0, At, B0); PG8_MMA(1, 1, At, B1); PG8_BAR; PG8_SCHED;
            PG8_LDB(B0, 1, 0); PG8_LDB(B1, 1, 1); PG8_SCHED; PG8_LDA(At, 1, 0); PG8_STAGE(PG8_SA(0, 1), a2 + hstep, voffA);
            PG8_WAIT_V(8); PG8_WAIT_L(0); PG8_BAR; PG8_MMA(0, 0, At, B0); PG8_MMA(0, 1, At, B1); PG8_BAR; PG8_SCHED;
            PG8_LDA(At, 1, 1); PG8_STAGE(PG8_SB(1, 0), b3, voffB); PG8_STAGE(PG8_SB(1, 1), b3 + hstep, voffB); PG8_STAGE(PG8_SA(1, 0), a3, voffA);
            PG8_WAIT_V(8); PG8_WAIT_L(0); PG8_BAR; PG8_MMA(1, 0, At, B0); PG8_MMA(1, 1, At, B1); PG8_BAR; PG8_SCHED;
            } else {
            PG8_LDB(B0, 0, 0); PG8_SCHED; PG8_LDA(At, 0, 0); PG8_STAGE(PG8_SA(1, 1), a1 + hstep, voffA);
            PG8_WAIT_L(8); PG8_BAR; PG8_WAIT_L(0); PG8_MMA(0, 0, At, B0); PG8_BAR; PG8_SCHED;
            PG8_LDB(B1, 0, 1); PG8_STAGE(PG8_SB(0, 0), b2, voffB);
            PG8_BAR; PG8_WAIT_L(0); PG8_MMA(0, 1, At, B1); PG8_BAR;
            PG8_LDA(At, 0, 1); PG8_STAGE(PG8_SA(0, 0), a2, voffA);
            PG8_BAR; PG8_WAIT_L(0); PG8_MMA(1, 0, At, B0); PG8_BAR; PG8_SCHED;
            PG8_STAGE(PG8_SB(0, 1), b2 + hstep, voffB);
            PG8_WAIT_V(6); PG8_BAR; PG8_MMA(1, 1, At, B1); PG8_BAR;
            PG8_LDB(B0, 1, 0); PG8_SCHED; PG8_LDA(At, 1, 0); PG8_STAGE(PG8_SA(0, 1), a2 + hstep, voffA);
            PG8_WAIT_L(8); PG8_BAR; PG8_WAIT_L(0); PG8_MMA(0, 0, At, B0); PG8_BAR; PG8_SCHED;
            PG8_LDB(B1, 1, 1); PG8_STAGE(PG8_SB(1, 0), b3, voffB);
            PG8_BAR; PG8_WAIT_L(0); PG8_MMA(0, 1, At, B1); PG8_BAR;
            PG8_LDA(At, 1, 1); PG8_STAGE(PG8_SA(1, 0), a3, voffA);
            PG8_BAR; PG8_WAIT_L(0); PG8_MMA(1, 0, At, B0); PG8_BAR; PG8_SCHED;
            PG8_STAGE(PG8_SB(1, 1), b3 + hstep, voffB);
            PG8_WAIT_V(6); PG8_BAR; PG8_MMA(1, 1, At, B1); PG8_BAR;
            }
        }
        if constexpr (ALIGN_EPI) { if (wr == 0) PG8_BAR; }
        if constexpr (!Epi::AFTER_DRAIN) { E(acc, cur, wr, wc, fr, fq); S.done(cur); }
        if (!has_next) break;
#pragma unroll
        for (int a = 0; a < 2; ++a)
#pragma unroll
            for (int b = 0; b < 2; ++b)
#pragma unroll
                for (int m = 0; m < 4; ++m)
#pragma unroll
                    for (int n = 0; n < 2; ++n) acc[a][b][m][n] = (f32x4){0.f, 0.f, 0.f, 0.f};
        cur = nxt; cA = nA; cB = nB; ++ui;
        if constexpr (ALIGN_EPI) { if (wr == 1) PG8_BAR; }
    }
    PG8_WAIT_V(0);
    if constexpr (!ALIGN_EPI) { if (wr == 0) PG8_BAR; }
    PG8_BAR;
    if constexpr (Epi::AFTER_DRAIN) { E.fused(acc, cur, wr, wc, fr, fq, lds, wid, lane); S.done(cur); }
#undef PG8_SA
#undef PG8_SB
#undef PG8_STAGE
#undef PG8_LDA
#undef PG8_LDB
#undef PG8_MMA
#undef PG8_WAIT_V
#undef PG8_WAIT_L
#undef PG8_BAR
#undef PG8_SCHED
}
}

#define GAS __attribute__((address_space(1)))
#define LAS __attribute__((address_space(3)))
typedef unsigned short bf16;
typedef unsigned v4u __attribute__((ext_vector_type(4)));
typedef float f32x4 __attribute__((ext_vector_type(4)));
typedef short bf16x8 __attribute__((ext_vector_type(8)));
typedef GAS unsigned gu32;
typedef GAS unsigned long long gu64;
#define RLX_AGENT __ATOMIC_RELAXED, __HIP_MEMORY_SCOPE_AGENT
#define LDS_WAIT() asm volatile("s_waitcnt lgkmcnt(0)" ::: "memory")
#define VM_WAIT() asm volatile("s_waitcnt vmcnt(0)" ::: "memory")
__device__ __forceinline__ unsigned long long rt() { return __builtin_amdgcn_s_memrealtime(); }
__device__ __forceinline__ unsigned f2bf(float f) { unsigned u = __builtin_bit_cast(unsigned, f); return (u + 0x7fffu + ((u >> 16) & 1u)) >> 16; }
__device__ __forceinline__ unsigned pk2(float lo, float hi) { return f2bf(lo) | (f2bf(hi) << 16); }

#define XB_TMO      128
#define XB_XCNT(j)  (256  + 64 * (j))
#define XB_XSUB(j)  (1280 + 64 * (j))
#define XB_XGEN(j)  (2304 + 64 * (j))
#define XB_TOP      3328
#define XB_TOPGEN   3392
#define XCD_BAR_WORDS 3456
#define XB_SPIN_CAP (1u << 18)

__device__ __forceinline__ unsigned xb_ld(unsigned* p)              { return __hip_atomic_load(p, __ATOMIC_RELAXED, __HIP_MEMORY_SCOPE_AGENT); }
__device__ __forceinline__ unsigned xb_add(unsigned* p, unsigned v) { return __hip_atomic_fetch_add(p, v, __ATOMIC_RELAXED, __HIP_MEMORY_SCOPE_AGENT); }
__device__ __forceinline__ unsigned xb_xcc_id() { return (unsigned)__builtin_amdgcn_s_getreg((3 << 11) | 20) & 0xFu; }
#define XB_SPIN(cond, bar) do { unsigned _sp = 0; while (cond) { __builtin_amdgcn_s_sleep(1); \
    if ((++_sp & 255u) == 0u) { if (xb_ld(&(bar)[XB_TMO])) break; if (_sp > XB_SPIN_CAP) { atomicAdd(&(bar)[XB_TMO], 1u); break; } } } } while (0)

struct XcdBarrier {
    unsigned* bar; unsigned x;
    volatile LAS unsigned* st;
};

__device__ __forceinline__ XcdBarrier xcd_barrier_post(unsigned* bar, volatile LAS unsigned* st) {
    XcdBarrier b; b.bar = bar; b.x = xb_xcc_id(); b.st = st;
    if (threadIdx.x == 0) (void)xb_add(&bar[XB_XCNT(b.x)], 1u);
    return b;
}
__device__ __forceinline__ void xcd_barrier_complete(unsigned* bar, unsigned x, unsigned& nloc, unsigned& nx) {
    const unsigned G = gridDim.x * gridDim.y * gridDim.z;
    unsigned sum, cnt, mine, sp = 0u;
    for (;;) {
        sum = 0u; cnt = 0u; mine = 0u;
#pragma unroll
        for (unsigned j = 0; j < 16; ++j) { const unsigned c = xb_ld(&bar[XB_XCNT(j)]); sum += c; cnt += (c > 0u) ? 1u : 0u; mine = (j == x) ? c : mine; }
        if (sum == G) break;
        __builtin_amdgcn_s_sleep(1);
        if ((++sp & 255u) == 0u) { if (xb_ld(&bar[XB_TMO])) break; if (sp > XB_SPIN_CAP) { atomicAdd(&bar[XB_TMO], 1u); break; } }
    }
    nloc = mine > 0u ? mine : 1u; nx = cnt > 0u ? cnt : 1u;
}

__device__ __forceinline__ void xcd_barrier(const XcdBarrier& b) {
    asm volatile("s_waitcnt vmcnt(0)" ::: "memory");
    __syncthreads();
    if (threadIdx.x == 0) {
        unsigned* bar = b.bar;
        __builtin_amdgcn_s_waitcnt(0);
        unsigned nloc = b.st[0], nx = b.st[1];
        if (nloc == 0u) { xcd_barrier_complete(bar, b.x, nloc, nx); b.st[0] = nloc; b.st[1] = nx; }
        const unsigned old = xb_add(&bar[XB_XSUB(b.x)], 1u);
        const unsigned gen = old / nloc;
        if (old + 1u == (gen + 1u) * nloc) {
            __builtin_amdgcn_fence(__ATOMIC_RELEASE, "agent");
            asm volatile("s_waitcnt vmcnt(0)" ::: "memory");
            const unsigned og = xb_add(&bar[XB_TOP], 1u);
            const unsigned tg = og / nx;
            if (og + 1u == (tg + 1u) * nx) xb_add(&bar[XB_TOPGEN], 1u);
            else XB_SPIN(xb_ld(&bar[XB_TOPGEN]) == tg, bar);
            __builtin_amdgcn_fence(__ATOMIC_ACQUIRE, "agent");
            xb_add(&bar[XB_XGEN(b.x)], 1u);
            asm volatile("s_waitcnt vmcnt(0)" ::: "memory");
        } else {
            XB_SPIN(xb_ld(&bar[XB_XGEN(b.x)]) == gen, bar);
            __builtin_amdgcn_fence(__ATOMIC_ACQUIRE, "agent");
            asm volatile("s_waitcnt vmcnt(0)" ::: "memory");
        }
    }
    __syncthreads();
}

constexpr int NWAVES = 8, NTHREADS = 512;
constexpr int BATCH = 8, SEQ = 2048, DM = 1024, T = BATCH * SEQ;
constexpr int NIN = 2560, MEMLEN = 256, TMEM = BATCH * MEMLEN;
constexpr int NEXP = 16384;
constexpr float LN_EPS = 1e-5f;
constexpr float DN_ALPHA = 1.189207115002721f;
constexpr float LOG2E = 1.4426950408889634f;
constexpr float QB_SCALE = 0.125f * LOG2E;
constexpr float XQ_SCALE = 0.0625f * LOG2E;
constexpr float EU_SCALE = 256.f, EV_SCALE = 16.f;

constexpr size_t MiB = 1u << 20;
constexpr size_t WS_CTL = 0, CTL_ZERO_BYTES = 1 * MiB;
constexpr size_t WS_WIN = 1 * MiB;
constexpr size_t WS_WOUT = 6 * MiB;
constexpr size_t WS_WXQ = 8 * MiB;
constexpr size_t WS_WXKV = 10 * MiB;
constexpr size_t WS_WXO = 14 * MiB;
constexpr size_t WS_WPQ = 16 * MiB;
constexpr size_t WS_SKB = 20 * MiB;
constexpr size_t WS_WSPM = 20 * MiB + 512 * 1024;
constexpr size_t WS_EU = 21 * MiB;
constexpr size_t WS_EV = 37 * MiB;
constexpr size_t WS_A = 85 * MiB;
constexpr size_t WS_PROJ = WS_A, WS_XQ = WS_A, WS_XO = WS_A + 32 * MiB, WS_PQ = WS_A;
constexpr size_t WS_B = 165 * MiB;
constexpr size_t WS_C = 197 * MiB;
constexpr size_t WS_MEMB = 229 * MiB;
constexpr size_t WS_XKV = 233 * MiB;
constexpr size_t WS_RIDX = 241 * MiB;
constexpr size_t WS_RGATE = 245 * MiB;
constexpr size_t WS_END = 253 * MiB;
constexpr int CW_BAR = 4096;

constexpr int SCRATCH_BYTES = 139264;
constexpr int LDSCTL_OFF = SCRATCH_BYTES;
constexpr int LDS_BYTES = SCRATCH_BYTES + 1024;

typedef short s16x4 __attribute__((ext_vector_type(4)));
typedef unsigned u32x2v __attribute__((ext_vector_type(2)));
typedef __bf16 v2bf16 __attribute__((ext_vector_type(2)));

struct Ctx { LAS unsigned char* lds; int tid, lane, wave, vcu, G; };

__device__ __forceinline__ float bf_lo(unsigned u) { return __uint_as_float(u << 16); }
__device__ __forceinline__ float bf_hi(unsigned u) { return __uint_as_float(u & 0xffff0000u); }
__device__ __forceinline__ float wave_sum(float v) {
#pragma unroll
    for (int o = 1; o < 64; o <<= 1) v += __shfl_xor(v, o);
    return v;
}
__device__ __forceinline__ bf16x8 pack8(f32x4 a, f32x4 b) {
    v4u w; w.x = pg8::cvt_pk_bf16(a[0], a[1]); w.y = pg8::cvt_pk_bf16(a[2], a[3]); w.z = pg8::cvt_pk_bf16(b[0], b[1]); w.w = pg8::cvt_pk_bf16(b[2], b[3]);
    return __builtin_bit_cast(bf16x8, w);
}
__device__ __forceinline__ s16x4 tr4(LAS unsigned char* p) { return __builtin_amdgcn_ds_read_tr16_b64_v4i16((LAS s16x4*)p); }
__device__ __forceinline__ bf16x8 cat8(s16x4 lo, s16x4 hi) { return (bf16x8){lo[0], lo[1], lo[2], lo[3], hi[0], hi[1], hi[2], hi[3]}; }
#define MFMA16(a, b, c) __builtin_amdgcn_mfma_f32_16x16x32_bf16((a), (b), (c), 0, 0, 0)

__device__ __forceinline__ void p0_transpose_item(const float* W, int K, int N, bf16* WT, int row_off, LAS float* scr, int item, int lane) {
    const int nblk = N / 32, kb = item / nblk, nb = item % nblk, k0 = 64 * kb, n0 = 32 * nb;
#pragma unroll 8
    for (int i = 0; i < 32; ++i) { const int kk = 2 * i + (lane >> 5); scr[kk * 33 + (lane & 31)] = W[(size_t)(k0 + kk) * N + n0 + (lane & 31)]; }
    LDS_WAIT(); asm volatile("" ::: "memory");
    const int c = lane & 7;
#pragma unroll
    for (int j = 0; j < 4; ++j) { const int n = (lane >> 3) + 8 * j; const LAS float* s = scr + (8 * c) * 33 + n;
        v4u o; o.x = pk2(s[0 * 33], s[1 * 33]); o.y = pk2(s[2 * 33], s[3 * 33]); o.z = pk2(s[4 * 33], s[5 * 33]); o.w = pk2(s[6 * 33], s[7 * 33]);
        *(GAS v4u*)(WT + (size_t)(row_off + n0 + n) * K + k0 + 8 * c) = o; }
    LDS_WAIT(); asm volatile("" ::: "memory");
}
__device__ __forceinline__ void cvt_f32_bf16(const float* src, bf16* dst, size_t n_elems, int gw, int NGW, int lane) {
    const size_t nitems = n_elems / 512;
#pragma unroll 4
    for (size_t it = gw; it < nitems; it += NGW) {
        const GAS f32x4* s = (const GAS f32x4*)(src + it * 512 + lane * 8);
        const f32x4 a = s[0], b = s[1];
        v4u o; o.x = pk2(a[0], a[1]); o.y = pk2(a[2], a[3]); o.z = pk2(b[0], b[1]); o.w = pk2(b[2], b[3]);
        *(GAS v4u*)(dst + it * 512 + lane * 8) = o;
    }
}
__device__ __forceinline__ void cvt_f32_fp8_rows(const float* src, unsigned char* dst, int nrows, float scale, int gw, int NGW, int lane) {
#pragma unroll 2
    for (int r = gw; r < nrows; r += NGW) {
        const GAS f32x4* s = (const GAS f32x4*)(src + (size_t)r * DM + lane * 16);
        const f32x4 a = s[0] * scale, b = s[1] * scale, c = s[2] * scale, d = s[3] * scale;
        v4u o;
        o.x = (unsigned)__builtin_amdgcn_cvt_pk_fp8_f32(a[2], a[3], __builtin_amdgcn_cvt_pk_fp8_f32(a[0], a[1], 0, false), true);
        o.y = (unsigned)__builtin_amdgcn_cvt_pk_fp8_f32(b[2], b[3], __builtin_amdgcn_cvt_pk_fp8_f32(b[0], b[1], 0, false), true);
        o.z = (unsigned)__builtin_amdgcn_cvt_pk_fp8_f32(c[2], c[3], __builtin_amdgcn_cvt_pk_fp8_f32(c[0], c[1], 0, false), true);
        o.w = (unsigned)__builtin_amdgcn_cvt_pk_fp8_f32(d[2], d[3], __builtin_amdgcn_cvt_pk_fp8_f32(d[0], d[1], 0, false), true);
        *(GAS v4u*)(dst + (size_t)r * DM + lane * 16) = o;
    }
}
__device__ __forceinline__ void ln_row_to_bf16(const float* xrow, const float* gam, const float* bet, bf16* orow, int lane) {
    const GAS f32x4* xr = (const GAS f32x4*)xrow + lane;
    f32x4 v[4]; float s = 0.f;
#pragma unroll
    for (int j = 0; j < 4; ++j) { v[j] = xr[64 * j]; s += (v[j][0] + v[j][1]) + (v[j][2] + v[j][3]); }
    const float mean = wave_sum(s) * (1.f / DM); float s2 = 0.f;
#pragma unroll
    for (int j = 0; j < 4; ++j) { v[j] = v[j] - mean; s2 += (v[j][0] * v[j][0] + v[j][1] * v[j][1]) + (v[j][2] * v[j][2] + v[j][3] * v[j][3]); }
    const float rstd = 1.f / sqrtf(wave_sum(s2) * (1.f / DM) + LN_EPS);
    GAS unsigned long long* o8 = (GAS unsigned long long*)orow + lane;
#pragma unroll
    for (int j = 0; j < 4; ++j) { const f32x4 gg = *((const GAS f32x4*)gam + lane + 64 * j), bb = *((const GAS f32x4*)bet + lane + 64 * j);
        const f32x4 y = v[j] * rstd * gg + bb;
        o8[64 * j] = (unsigned long long)pk2(y[0], y[1]) | ((unsigned long long)pk2(y[2], y[3]) << 32); }
}
struct P0Args { const float *x, *mem, *ln_g, *ln_b, *w_in, *w_sp, *w_out, *w_xq, *w_xk, *w_xv, *w_xo, *w_pq, *sub_keys, *eu, *ev;
                bf16 *WIN, *WOUT, *WXQ, *WXKV, *WXO, *WPQ, *SKB, *WSPM; unsigned char *EU, *EV; bf16 *H0, *MEMB; };
__device__ __forceinline__ void p0_prologue(const Ctx& C, const P0Args& a) {
    LAS float* scr = (LAS float*)(C.lds + C.wave * 16384);
    const int gw = C.vcu * NWAVES + C.wave, NGW = C.G * NWAVES, lane = C.lane;
    constexpr int I_IN = 16 * (NIN / 32), I_SQ = 16 * (DM / 32), I_PQ = 16 * (2048 / 32);
    constexpr int NITEMS = I_IN + 5 * I_SQ + I_PQ;
    for (int it = gw; it < NITEMS; it += NGW) {
        int r = it;
        if (r < I_IN) { p0_transpose_item(a.w_in, DM, NIN, a.WIN, 0, scr, r, lane); continue; } r -= I_IN;
        if (r < I_SQ) { p0_transpose_item(a.w_out, DM, DM, a.WOUT, 0, scr, r, lane); continue; } r -= I_SQ;
        if (r < I_SQ) { p0_transpose_item(a.w_xq, DM, DM, a.WXQ, 0, scr, r, lane); continue; } r -= I_SQ;
        if (r < I_SQ) { p0_transpose_item(a.w_xk, DM, DM, a.WXKV, 0, scr, r, lane); continue; } r -= I_SQ;
        if (r < I_SQ) { p0_transpose_item(a.w_xv, DM, DM, a.WXKV, DM, scr, r, lane); continue; } r -= I_SQ;
        if (r < I_SQ) { p0_transpose_item(a.w_xo, DM, DM, a.WXO, 0, scr, r, lane); continue; } r -= I_SQ;
        p0_transpose_item(a.w_pq, DM, 2048, a.WPQ, 0, scr, r, lane);
    }
    for (int m = gw; m < T; m += NGW) ln_row_to_bf16(a.x + (size_t)m * DM, a.ln_g, a.ln_b, a.H0 + (size_t)m * DM, lane);
    cvt_f32_bf16(a.mem, a.MEMB, (size_t)TMEM * DM, gw, NGW, lane);
    cvt_f32_bf16(a.sub_keys, a.SKB, (size_t)16 * 128 * 128, gw, NGW, lane);
    for (int it = gw; it < 4 * 128 * 128 / 512; it += NGW) {
        const int e0 = it * 512 + lane * 8, i = (e0 >> 7) & 127, j = e0 & 127; const bool keep = !(i < 64 && j >= 64);
        const GAS f32x4* s = (const GAS f32x4*)(a.w_sp + e0); const f32x4 p = s[0], q = s[1];
        v4u o; o.x = pk2(p[0], p[1]); o.y = pk2(p[2], p[3]); o.z = pk2(q[0], q[1]); o.w = pk2(q[2], q[3]);
        if (!keep) o = (v4u){0u, 0u, 0u, 0u};
        *(GAS v4u*)(a.WSPM + e0) = o;
    }
    cvt_f32_fp8_rows(a.eu, a.EU, NEXP, EU_SCALE, gw, NGW, lane);
    cvt_f32_fp8_rows(a.ev, a.EV, NEXP, EV_SCALE, gw, NGW, lane);
}
__device__ __forceinline__ void ln_pass(const Ctx& C, const float* Z, const float* gam, const float* bet, bf16* H) {
    const int gw = C.vcu * NWAVES + C.wave, NGW = C.G * NWAVES;
    for (int m = gw; m < T; m += NGW) ln_row_to_bf16(Z + (size_t)m * DM, gam, bet, H + (size_t)m * DM, C.lane);
}

__device__ __forceinline__ void chunk_attn_unit(const Ctx& C, const bf16* PROJ, bf16* MIXIN, const float* rel_bias, int b, int h, int cp) {
    LAS unsigned char* lds = C.lds;
    LAS float* rb = (LAS float*)(lds + 18432);
    const int lane = C.lane, w = C.wave, g = lane >> 4, li = lane & 15;
    __syncthreads();
    for (int i = C.tid; i < 257; i += NTHREADS) rb[i] = rel_bias[h * 257 + i] * LOG2E;
    const int c = 2 * cp + (w >> 2), qt = w & 3, qi = 16 * qt + li;
    const size_t tok = (size_t)b * SEQ + 64 * c + qi;
    bf16x8 qf[2];
#pragma unroll
    for (int ks = 0; ks < 2; ++ks) qf[ks] = *(const GAS bf16x8*)(PROJ + tok * NIN + 1024 + h * 64 + 32 * ks + 8 * g);
    float m = -1e30f, l = 0.f; f32x4 O[4];
#pragma unroll
    for (int dt = 0; dt < 4; ++dt) O[dt] = (f32x4){0.f, 0.f, 0.f, 0.f};
    for (int kc = 2 * cp - 8; kc <= 2 * cp + 1; ++kc) {
        if (kc < 0) continue;
        __syncthreads();
        { const int row = C.tid >> 3, ch = C.tid & 7;
          const bf16* src = PROJ + ((size_t)b * SEQ + 64 * kc + row) * NIN + 1536 + h * 64 + ch * 8;
          const v4u kv = *(const GAS v4u*)src, vv = *(const GAS v4u*)(src + 512);
          *(LAS v4u*)(lds + row * 144 + ch * 16) = kv; *(LAS v4u*)(lds + 9216 + row * 144 + ch * 16) = vv; }
        __syncthreads();
        if (kc >= c - 8 && kc <= c) {
            f32x4 s[4];
#pragma unroll
            for (int mt = 0; mt < 4; ++mt) { s[mt] = (f32x4){0.f, 0.f, 0.f, 0.f};
#pragma unroll
                for (int ks = 0; ks < 2; ++ks) { const bf16x8 a = *(const LAS bf16x8*)(lds + (16 * mt + li) * 144 + (32 * ks + 8 * g) * 2); s[mt] = MFMA16(a, qf[ks], s[mt]); } }
            const int dch = c - kc;
            if (dch >= 3) { const float bc = rb[256];
#pragma unroll
                for (int mt = 0; mt < 4; ++mt) s[mt] = s[mt] + bc;
            } else {
#pragma unroll
                for (int mt = 0; mt < 4; ++mt)
#pragma unroll
                    for (int r = 0; r < 4; ++r) { const int kj = 16 * mt + 4 * g + r; int dist = 64 * dch + qi - kj; dist = dist > 128 ? 128 : dist; s[mt][r] += rb[dist + 128]; }
            }
            float mx = -1e30f;
#pragma unroll
            for (int mt = 0; mt < 4; ++mt) mx = fmaxf(mx, fmaxf(fmaxf(s[mt][0], s[mt][1]), fmaxf(s[mt][2], s[mt][3])));
            mx = fmaxf(mx, __shfl_xor(mx, 16)); mx = fmaxf(mx, __shfl_xor(mx, 32));
            const float mn = fmaxf(m, mx), alpha = __builtin_amdgcn_exp2f(m - mn); m = mn;
            float rs = 0.f;
#pragma unroll
            for (int mt = 0; mt < 4; ++mt)
#pragma unroll
                for (int r = 0; r < 4; ++r) { s[mt][r] = __builtin_amdgcn_exp2f(s[mt][r] - mn); rs += s[mt][r]; }
            rs += __shfl_xor(rs, 16); rs += __shfl_xor(rs, 32);
            l = l * alpha + rs;
#pragma unroll
            for (int dt = 0; dt < 4; ++dt) O[dt] = O[dt] * alpha;
            bf16x8 pf[2]; pf[0] = pack8(s[0], s[1]); pf[1] = pack8(s[2], s[3]);
#pragma unroll
            for (int dt = 0; dt < 4; ++dt)
#pragma unroll
                for (int kk = 0; kk < 2; ++kk) {
                    LAS unsigned char* p = lds + 9216 + (32 * kk + 4 * g + (li >> 2)) * 144 + (16 * dt + 4 * (li & 3)) * 2;
                    const s16x4 lo = tr4(p), hi = tr4(p + 16 * 144);
                    O[dt] = MFMA16(cat8(lo, hi), pf[kk], O[dt]);
                }
        }
    }
    const float il = 1.f / l;
#pragma unroll
    for (int dt = 0; dt < 4; ++dt) { const f32x4 o = O[dt] * il; u32x2v wv; wv.x = pg8::cvt_pk_bf16(o[0], o[1]); wv.y = pg8::cvt_pk_bf16(o[2], o[3]);
        *(GAS u32x2v*)(MIXIN + tok * DM + 512 + 64 * h + 16 * dt + 4 * g) = wv; }
}
__device__ __forceinline__ void gmlp_unit(const Ctx& C, const bf16* PROJ, bf16* MIXIN, const bf16* WSPM, const float* b_sp, const float* gln_g, const float* gln_b, int blk, int grp) {
    LAS unsigned char* lds = C.lds; constexpr int WOFF = 34816;
    const int lane = C.lane, w = C.wave, g = lane >> 4, li = lane & 15;
    __syncthreads();
#pragma unroll
    for (int i = 0; i < 4; ++i) { const int ch = C.tid + NTHREADS * i, row = ch >> 4, cc = ch & 15;
        *(LAS v4u*)(lds + WOFF + row * 272 + cc * 16) = *(const GAS v4u*)(WSPM + grp * 16384 + row * 128 + cc * 8); }
    f32x4 gg0, gg1, bb0, bb1;
    { const GAS f32x4* gp = (const GAS f32x4*)(gln_g + lane * 8); gg0 = gp[0]; gg1 = gp[1]; const GAS f32x4* bp = (const GAS f32x4*)(gln_b + lane * 8); bb0 = bp[0]; bb1 = bp[1]; }
    for (int rr = 0; rr < 16; ++rr) {
        const int row = 16 * w + rr;
        const v4u raw = *(const GAS v4u*)(PROJ + ((size_t)blk * 128 + row) * NIN + 512 + lane * 8);
        f32x4 v0 = {bf_lo(raw.x), bf_hi(raw.x), bf_lo(raw.y), bf_hi(raw.y)}, v1 = {bf_lo(raw.z), bf_hi(raw.z), bf_lo(raw.w), bf_hi(raw.w)};
        const float mean = wave_sum((v0[0] + v0[1]) + (v0[2] + v0[3]) + (v1[0] + v1[1]) + (v1[2] + v1[3])) * (1.f / 512.f);
        v0 = v0 - mean; v1 = v1 - mean;
        const float var = wave_sum((v0[0] * v0[0] + v0[1] * v0[1]) + (v0[2] * v0[2] + v0[3] * v0[3]) + (v1[0] * v1[0] + v1[1] * v1[1]) + (v1[2] * v1[2] + v1[3] * v1[3])) * (1.f / 512.f);
        const float rstd = 1.f / sqrtf(var + LN_EPS);
        if (g == grp) { const f32x4 y0 = v0 * rstd * gg0 + bb0, y1 = v1 * rstd * gg1 + bb1; *(LAS bf16x8*)(lds + row * 272 + li * 16) = pack8(y0, y1); }
    }
    __syncthreads();
    f32x4 acc[8];
#pragma unroll
    for (int mt = 0; mt < 8; ++mt) acc[mt] = (f32x4){0.f, 0.f, 0.f, 0.f};
    const int nks = (w < 4) ? 2 : 4;
    for (int ks = 0; ks < nks; ++ks) {
        const bf16x8 bw = *(const LAS bf16x8*)(lds + WOFF + (16 * w + li) * 272 + (32 * ks + 8 * g) * 2);
#pragma unroll
        for (int mt = 0; mt < 8; ++mt) {
            LAS unsigned char* p = lds + (32 * ks + 8 * g + (li >> 2)) * 272 + (16 * mt + 4 * (li & 3)) * 2;
            const s16x4 lo = tr4(p), hi = tr4(p + 4 * 272);
            acc[mt] = MFMA16(cat8(lo, hi), bw, acc[mt]);
        }
    }
    const int i = 16 * w + li; const size_t row = (size_t)blk * 128 + i; const float bias = b_sp[grp * 128 + i];
#pragma unroll
    for (int mt = 0; mt < 8; ++mt) { const int c0 = 128 * grp + 16 * mt + 4 * g;
        const u32x2v ur = *(const GAS u32x2v*)(PROJ + row * NIN + c0);
        const f32x4 sv = acc[mt] + bias;
        u32x2v wv; wv.x = pg8::cvt_pk_bf16(bf_lo(ur.x) * sv[0], bf_hi(ur.x) * sv[1]); wv.y = pg8::cvt_pk_bf16(bf_lo(ur.y) * sv[2], bf_hi(ur.y) * sv[3]);
        *(GAS u32x2v*)(MIXIN + row * DM + c0) = wv; }
}

__device__ __forceinline__ void xattn_unit(const Ctx& C, const bf16* XQ, const bf16* XKV, bf16* XO, int b, int xh, int qt8) {
    LAS unsigned char* lds = C.lds;
    const int lane = C.lane, w = C.wave, g = lane >> 4, li = lane & 15;
    const size_t tok = (size_t)b * SEQ + 128 * qt8 + 16 * w + li;
    bf16x8 qf[8];
#pragma unroll
    for (int ks = 0; ks < 8; ++ks) qf[ks] = *(const GAS bf16x8*)(XQ + tok * DM + 256 * xh + 32 * ks + 8 * g);
    __syncthreads();
    {   v4u t[16];
#pragma unroll
        for (int i = 0; i < 16; ++i) { const int ch = C.tid + NTHREADS * i, row = ch >> 5, cc = ch & 31; t[i] = *(const GAS v4u*)(XKV + ((size_t)b * MEMLEN + row) * 2048 + 256 * xh + cc * 8); }
#pragma unroll
        for (int i = 0; i < 16; ++i) { const int ch = C.tid + NTHREADS * i, row = ch >> 5, cc = ch & 31; *(LAS v4u*)(lds + row * 544 + cc * 16) = t[i]; } }
    __syncthreads();
    f32x4 s[16];
#pragma unroll
    for (int mt = 0; mt < 16; ++mt) { s[mt] = (f32x4){0.f, 0.f, 0.f, 0.f};
#pragma unroll
        for (int ks = 0; ks < 8; ++ks) { const bf16x8 a = *(const LAS bf16x8*)(lds + (16 * mt + li) * 544 + (32 * ks + 8 * g) * 2); s[mt] = MFMA16(a, qf[ks], s[mt]); } }
    float mx = -1e30f;
#pragma unroll
    for (int mt = 0; mt < 16; ++mt) mx = fmaxf(mx, fmaxf(fmaxf(s[mt][0], s[mt][1]), fmaxf(s[mt][2], s[mt][3])));
    mx = fmaxf(mx, __shfl_xor(mx, 16)); mx = fmaxf(mx, __shfl_xor(mx, 32));
    float rs = 0.f;
#pragma unroll
    for (int mt = 0; mt < 16; ++mt)
#pragma unroll
        for (int r = 0; r < 4; ++r) { s[mt][r] = __builtin_amdgcn_exp2f(s[mt][r] - mx); rs += s[mt][r]; }
    rs += __shfl_xor(rs, 16); rs += __shfl_xor(rs, 32);
    const float il = 1.f / rs;
    bf16x8 pf[8];
#pragma unroll
    for (int kk = 0; kk < 8; ++kk) pf[kk] = pack8(s[2 * kk], s[2 * kk + 1]);
    __syncthreads();
    {   v4u t[16];
#pragma unroll
        for (int i = 0; i < 16; ++i) { const int ch = C.tid + NTHREADS * i, row = ch >> 5, cc = ch & 31; t[i] = *(const GAS v4u*)(XKV + ((size_t)b * MEMLEN + row) * 2048 + 1024 + 256 * xh + cc * 8); }
#pragma unroll
        for (int i = 0; i < 16; ++i) { const int ch = C.tid + NTHREADS * i, row = ch >> 5, cc = ch & 31; *(LAS v4u*)(lds + row * 544 + cc * 16) = t[i]; } }
    __syncthreads();
#pragma unroll 4
    for (int dt = 0; dt < 16; ++dt) {
        f32x4 o = {0.f, 0.f, 0.f, 0.f};
#pragma unroll
        for (int kk = 0; kk < 8; ++kk) {
            LAS unsigned char* p = lds + (32 * kk + 4 * g + (li >> 2)) * 544 + (16 * dt + 4 * (li & 3)) * 2;
            const s16x4 lo = tr4(p), hi = tr4(p + 16 * 544);
            o = MFMA16(cat8(lo, hi), pf[kk], o);
        }
        o = o * il; u32x2v wv; wv.x = pg8::cvt_pk_bf16(o[0], o[1]); wv.y = pg8::cvt_pk_bf16(o[2], o[3]);
        *(GAS u32x2v*)(XO + tok * DM + 256 * xh + 16 * dt + 4 * g) = wv;
    }
}

__device__ __forceinline__ unsigned ord_key(float x) { const unsigned u = __float_as_uint(x); return u ^ ((unsigned)((int)u >> 31) | 0x80000000u); }
__device__ __forceinline__ float ord_val(unsigned k) { return __uint_as_float(k ^ ((k & 0x80000000u) ? 0x80000000u : 0xffffffffu)); }
#define CEX_DESC(a, b) do { const unsigned _h = (a) > (b) ? (a) : (b), _l = (a) > (b) ? (b) : (a); (a) = _h; (b) = _l; } while (0)
template <int N> __device__ __forceinline__ void bitonic_sort_desc(unsigned (&v)[N]) {
#pragma unroll
    for (int k = 2; k <= N; k <<= 1)
#pragma unroll
        for (int j = k >> 1; j > 0; j >>= 1)
#pragma unroll
            for (int i = 0; i < N; ++i) { const int p = i ^ j; if (p > i) { if ((i & k) == 0) CEX_DESC(v[i], v[p]); else CEX_DESC(v[p], v[i]); } }
}
__device__ __forceinline__ void bitonic_merge16_desc(unsigned (&v)[16]) {
#pragma unroll
    for (int j = 8; j > 0; j >>= 1)
#pragma unroll
        for (int i = 0; i < 16; ++i) { const int p = i ^ j; if (p > i) CEX_DESC(v[i], v[p]); }
}
__device__ __forceinline__ void merge_xor(unsigned (&L)[16], int d) {
    unsigned o[16];
#pragma unroll
    for (int i = 0; i < 16; ++i) o[i] = (unsigned)__shfl_xor((int)L[i], d);
#pragma unroll
    for (int i = 0; i < 16; ++i) L[i] = L[i] > o[15 - i] ? L[i] : o[15 - i];
    bitonic_merge16_desc(L);
}
__host__ __device__ constexpr int cand_code(int n) {
    int cnt = 0;
    for (int i = 0; i < 16; ++i) for (int j = 0; j < 16; ++j) if ((i + 1) * (j + 1) <= 16) { if (cnt == n) return (i << 4) | j; ++cnt; }
    return -1;
}
template <int CODE> __device__ __forceinline__ unsigned cand_mk(const float (&va)[16], const float (&vb)[16]) {
    if constexpr (CODE >= 0) { const float sm = va[(CODE >> 4) & 15] + vb[CODE & 15]; return (ord_key(sm) & ~255u) | (unsigned)CODE; } else return 0u;
}
template <int TT> __device__ __forceinline__ unsigned cand_key(const float (&va)[16], const float (&vb)[16], int g) {
    const unsigned k0 = cand_mk<cand_code(TT)>(va, vb), k1 = cand_mk<cand_code(16 + TT)>(va, vb), k2 = cand_mk<cand_code(32 + TT)>(va, vb), k3 = cand_mk<cand_code(48 + TT)>(va, vb);
    return g == 0 ? k0 : (g == 1 ? k1 : (g == 2 ? k2 : k3));
}
__device__ __forceinline__ void route_unit(const Ctx& C, const bf16* PQ, const bf16* SKB, unsigned short* RIDX, float* RGATE, int tile, int h, float* dbg) {
    LAS unsigned char* lds = C.lds;
    const int lane = C.lane, w = C.wave, g = lane >> 4, li = lane & 15;
    __syncthreads();
#pragma unroll
    for (int i = 0; i < 8; ++i) { const int ch = C.tid + NTHREADS * i, p = ch >> 11, row = (ch >> 4) & 127, cc = ch & 15;
        *(LAS v4u*)(lds + p * 34816 + row * 272 + cc * 16) = *(const GAS v4u*)(SKB + ((size_t)(2 * h + p) * 128 + row) * 128 + cc * 8); }
    __syncthreads();
    const size_t tok = (size_t)tile * 128 + 16 * w + li;
    unsigned La[16], Lb[16];
#pragma unroll
    for (int p = 0; p < 2; ++p) {
        bf16x8 qf[4];
#pragma unroll
        for (int ks = 0; ks < 4; ++ks) qf[ks] = *(const GAS bf16x8*)(PQ + tok * 2048 + 256 * h + 128 * p + 32 * ks + 8 * g);
        unsigned key[32];
#pragma unroll
        for (int mt = 0; mt < 8; ++mt) { f32x4 sc = {0.f, 0.f, 0.f, 0.f};
#pragma unroll
            for (int ks = 0; ks < 4; ++ks) { const bf16x8 a = *(const LAS bf16x8*)(lds + p * 34816 + (16 * mt + li) * 272 + (32 * ks + 8 * g) * 2); sc = MFMA16(a, qf[ks], sc); }
#pragma unroll
            for (int r = 0; r < 4; ++r) key[4 * mt + r] = (ord_key(sc[r]) & ~127u) | (unsigned)(16 * mt + 4 * g + r); }
        bitonic_sort_desc<32>(key);
        unsigned L[16];
#pragma unroll
        for (int i = 0; i < 16; ++i) L[i] = key[i];
        merge_xor(L, 16); merge_xor(L, 32);
#pragma unroll
        for (int i = 0; i < 16; ++i) { if (p == 0) La[i] = L[i]; else Lb[i] = L[i]; }
    }
#if DBG_STAT == 10
    if (g == 0) {
        float best = -1e30f; int bi = -1;
        for (int k = 0; k < 128; ++k) { float a = 0.f;
            for (int d = 0; d < 128; ++d) a += bf_lo((unsigned)PQ[tok * 2048 + 256 * h + d]) * bf_lo((unsigned)SKB[((size_t)(2 * h) * 128 + k) * 128 + d]);
            if (a > best) { best = a; bi = k; } }
        if (bi != (int)(La[0] & 127u)) atomicAdd(dbg, 1.f / (float)(T * 8));
    }
#endif
    float va[16], vb[16];
#pragma unroll
    for (int i = 0; i < 16; ++i) { va[i] = ord_val(La[i] & ~127u); vb[i] = ord_val(Lb[i] & ~127u); }
    unsigned F[16];
#define CANDT(t) F[t] = cand_key<t>(va, vb, g);
    CANDT(0) CANDT(1) CANDT(2) CANDT(3) CANDT(4) CANDT(5) CANDT(6) CANDT(7) CANDT(8) CANDT(9) CANDT(10) CANDT(11) CANDT(12) CANDT(13) CANDT(14) CANDT(15)
#undef CANDT
    bitonic_sort_desc<16>(F);
    merge_xor(F, 16); merge_xor(F, 32);
    unsigned da = La[0] & 127u, db = Lb[0] & 127u;
#pragma unroll
    for (int n = 1; n < 16; ++n) { da = li == n ? (La[n] & 127u) : da; db = li == n ? (Lb[n] & 127u) : db; }
    float gv[16], gs = 0.f; const float g0 = ord_val(F[0] & ~255u);
#pragma unroll
    for (int k = 0; k < 16; ++k) { gv[k] = __builtin_amdgcn_exp2f((ord_val(F[k] & ~255u) - g0) * LOG2E); gs += gv[k]; }
    const float ig = 1.f / gs;
#pragma unroll
    for (int k = 0; k < 16; ++k) {
        const int ci = (F[k] >> 4) & 15, cj = F[k] & 15;
        int i1 = 0, i2 = 0;
#pragma unroll
        for (int n = 0; n < 16; ++n) { i1 = ci == n ? (int)(La[n] & 127u) : i1; i2 = cj == n ? (int)(Lb[n] & 127u) : i2; }
        if (g == 0) { RIDX[tok * 128 + 16 * h + k] = (unsigned short)(i1 * 128 + i2); RGATE[tok * 128 + 16 * h + k] = gv[k] * ig; }
#if DBG_STAT == 12
        if (k == 0 && g == 0 && (i1 * 128 + i2) != (int)((La[0] & 127u) * 128u + (Lb[0] & 127u))) atomicAdd(dbg, 1.f / (float)(T * 8));
        if (k == 1 && g == 0) { const int e01 = (int)((La[0] & 127u) * 128u + (Lb[1] & 127u)), e10 = (int)((La[1] & 127u) * 128u + (Lb[0] & 127u)); if ((i1 * 128 + i2) != e01 && (i1 * 128 + i2) != e10) atomicAdd(dbg, 1.f / (float)(T * 8)); }
#endif
    }
}

__device__ __forceinline__ float dot2u(unsigned a, unsigned b, float acc) {
    return __builtin_amdgcn_fdot2_f32_bf16(__builtin_bit_cast(v2bf16, a), __builtin_bit_cast(v2bf16, b), acc, false);
}
__device__ __forceinline__ float dot8(v4u a, v4u b, float acc) {
    const unsigned a0 = a.x, a1 = a.y, a2 = a.z, a3 = a.w, b0 = b.x, b1 = b.y, b2 = b.z, b3 = b.w;
    acc = dot2u(a0, b0, acc); acc = dot2u(a1, b1, acc); acc = dot2u(a2, b2, acc); acc = dot2u(a3, b3, acc);
    return acc;
}
typedef float f32x2v __attribute__((ext_vector_type(2)));
__device__ __forceinline__ void unpack16(v4u w, float (&f)[16]) {
    const unsigned w0 = w.x, w1 = w.y, w2 = w.z, w3 = w.w;
    f32x2v t;
    t = __builtin_amdgcn_cvt_pk_f32_fp8((int)w0, false); f[0] = t.x; f[1] = t.y;   t = __builtin_amdgcn_cvt_pk_f32_fp8((int)w0, true); f[2] = t.x; f[3] = t.y;
    t = __builtin_amdgcn_cvt_pk_f32_fp8((int)w1, false); f[4] = t.x; f[5] = t.y;   t = __builtin_amdgcn_cvt_pk_f32_fp8((int)w1, true); f[6] = t.x; f[7] = t.y;
    t = __builtin_amdgcn_cvt_pk_f32_fp8((int)w2, false); f[8] = t.x; f[9] = t.y;   t = __builtin_amdgcn_cvt_pk_f32_fp8((int)w2, true); f[10] = t.x; f[11] = t.y;
    t = __builtin_amdgcn_cvt_pk_f32_fp8((int)w3, false); f[12] = t.x; f[13] = t.y; t = __builtin_amdgcn_cvt_pk_f32_fp8((int)w3, true); f[14] = t.x; f[15] = t.y;
}
__device__ __forceinline__ void expert_phase(const Ctx& C, const bf16* H2, const unsigned char* EU, const unsigned char* EV, const unsigned short* RIDX, const float* RGATE,
                                             const float* g3, const float* b3, float* out, float* dbg) {
    const int lane = C.lane;
    const int gw = C.vcu * NWAVES + C.wave, NGW = C.G * NWAVES;
    for (int tok = gw; tok < T; tok += NGW) {
        const v4u x0 = *(const GAS v4u*)(H2 + (size_t)tok * DM + lane * 16), x1 = *(const GAS v4u*)(H2 + (size_t)tok * DM + lane * 16 + 8);
        float xf[16];
        xf[0] = bf_lo(x0.x); xf[1] = bf_hi(x0.x); xf[2] = bf_lo(x0.y); xf[3] = bf_hi(x0.y); xf[4] = bf_lo(x0.z); xf[5] = bf_hi(x0.z); xf[6] = bf_lo(x0.w); xf[7] = bf_hi(x0.w);
        xf[8] = bf_lo(x1.x); xf[9] = bf_hi(x1.x); xf[10] = bf_lo(x1.y); xf[11] = bf_hi(x1.y); xf[12] = bf_lo(x1.z); xf[13] = bf_hi(x1.z); xf[14] = bf_lo(x1.w); xf[15] = bf_hi(x1.w);
        const int e_lo = RIDX[(size_t)tok * 128 + lane], e_hi = RIDX[(size_t)tok * 128 + 64 + lane];
        const float g_lo = RGATE[(size_t)tok * 128 + lane], g_hi = RGATE[(size_t)tok * 128 + 64 + lane];
        float o[16];
#pragma unroll
        for (int i = 0; i < 16; ++i) o[i] = 0.f;
        for (int b8 = 0; b8 < ((DBG_MASK & 4) ? 0 : 8); ++b8) {
            const int ev = b8 < 4 ? e_lo : e_hi; const float gvv = b8 < 4 ? g_lo : g_hi; const int lb = 16 * (b8 & 3);
            float d[16];
            {   v4u uw[16];
#pragma unroll
                for (int kk = 0; kk < 16; ++kk) { const int e = __builtin_amdgcn_readlane(ev, lb + kk); uw[kk] = *(const GAS v4u*)(EU + (size_t)e * DM + lane * 16); }
#pragma unroll
                for (int kk = 0; kk < 16; ++kk) { float f[16]; unpack16(uw[kk], f); float a0 = 0.f, a1 = 0.f;
#pragma unroll
                    for (int i = 0; i < 16; i += 2) { a0 += f[i] * xf[i]; a1 += f[i + 1] * xf[i + 1]; }
                    d[kk] = a0 + a1; }
            }
            float r8[8], r4[4], r2[2], r1;
            { const bool hi = (lane & 32) != 0;
#pragma unroll
              for (int i = 0; i < 8; ++i) { const float keep = hi ? d[i + 8] : d[i], send = hi ? d[i] : d[i + 8]; r8[i] = keep + __shfl_xor(send, 32); } }
            { const bool hi = (lane & 16) != 0;
#pragma unroll
              for (int i = 0; i < 4; ++i) { const float keep = hi ? r8[i + 4] : r8[i], send = hi ? r8[i] : r8[i + 4]; r4[i] = keep + __shfl_xor(send, 16); } }
            { const bool hi = (lane & 8) != 0;
#pragma unroll
              for (int i = 0; i < 2; ++i) { const float keep = hi ? r4[i + 2] : r4[i], send = hi ? r4[i] : r4[i + 2]; r2[i] = keep + __shfl_xor(send, 8); } }
            { const bool hi = (lane & 4) != 0; const float keep = hi ? r2[1] : r2[0], send = hi ? r2[0] : r2[1]; r1 = keep + __shfl_xor(send, 4); }
            r1 += __shfl_xor(r1, 2); r1 += __shfl_xor(r1, 1);
            r1 *= (1.f / EU_SCALE);
            const float gate = __shfl(gvv, lb + ((lane >> 2) & 15));
            const float av = gate * pg8::gelu1(r1) * (1.f / EV_SCALE);
            {   v4u vw[16];
#pragma unroll
                for (int kk = 0; kk < 16; ++kk) { const int e = __builtin_amdgcn_readlane(ev, lb + kk); vw[kk] = *(const GAS v4u*)(EV + (size_t)e * DM + lane * 16); }
#pragma unroll
                for (int kk = 0; kk < 16; ++kk) { float f[16]; unpack16(vw[kk], f); const float ak = __uint_as_float(__builtin_amdgcn_readlane(__float_as_uint(av), 4 * kk));
#pragma unroll
                    for (int i = 0; i < 16; ++i) o[i] += ak * f[i]; }
            }
        }
        float s = 0.f;
#pragma unroll
        for (int i = 0; i < 16; ++i) { o[i] = DN_ALPHA * xf[i] + o[i]; s += o[i]; }
        const float mean = wave_sum(s) * (1.f / DM); float s2 = 0.f;
#pragma unroll
        for (int i = 0; i < 16; ++i) { o[i] -= mean; s2 += o[i] * o[i]; }
        const float rstd = 1.f / sqrtf(wave_sum(s2) * (1.f / DM) + LN_EPS);
        const GAS f32x4* gp = (const GAS f32x4*)(g3 + lane * 16); const GAS f32x4* bp = (const GAS f32x4*)(b3 + lane * 16);
        GAS f32x4* op = (GAS f32x4*)(out + (size_t)tok * DM + lane * 16);
#pragma unroll
        for (int q = 0; q < 4; ++q) op[q] = (f32x4){o[4 * q], o[4 * q + 1], o[4 * q + 2], o[4 * q + 3]} * rstd * gp[q] + bp[q];
    }
}

constexpr int NPHASES = 12 + (DBG_STAT ? 1 : 0);
struct Args { const float* in[25]; float* out; unsigned char* ws; int ph_lo, ph_hi, li, pad; };
__global__ void __launch_bounds__(NTHREADS, 2) fwd_kernel(Args args) {
    extern __shared__ __attribute__((aligned(16))) unsigned char lds_raw[];
    Ctx C;
    C.lds = (LAS unsigned char*)lds_raw;
    C.tid = threadIdx.x; C.lane = C.tid & 63; C.wave = __builtin_amdgcn_readfirstlane(C.tid >> 6);
    C.G = gridDim.x; { const int bx = blockIdx.x; C.vcu = (C.G % 8 == 0) ? (bx % 8) * (C.G / 8) + bx / 8 : bx; }
    volatile LAS unsigned* MISC = (volatile LAS unsigned*)(C.lds + LDSCTL_OFF);
    unsigned char* ws = args.ws;
    gu32* ctl = (gu32*)(ws + WS_CTL);
    for (int u = C.tid; u < (LDS_BYTES - LDSCTL_OFF) / 4; u += NTHREADS) ((LAS unsigned*)(C.lds + LDSCTL_OFF))[u] = 0u;
    __syncthreads();
    const int lo = args.ph_lo, hi = args.ph_hi;
    const bool multi = (hi - lo) > 1;
    XcdBarrier bar; bar.bar = (unsigned*)(ctl + CW_BAR) + args.li * XCD_BAR_WORDS; bar.x = 0; bar.st = nullptr;
    if (multi) bar = xcd_barrier_post((unsigned*)(ctl + CW_BAR) + args.li * XCD_BAR_WORDS, MISC + 8);
#define IN(k) (lo <= (k) && (k) < hi)
#define SEAM(k) do { if (IN(k) && IN((k) + 1)) xcd_barrier(bar); } while (0)

    const float* x = args.in[0]; const float* mem = args.in[1]; const float* ln_in_g = args.in[2]; const float* ln_in_b = args.in[3]; const float* w_in = args.in[4];
    const float* gate_ln_g = args.in[5]; const float* gate_ln_b = args.in[6]; const float* w_sp = args.in[7]; const float* b_sp = args.in[8]; const float* rel_bias = args.in[9];
    const float* w_out = args.in[10]; const float* ln1_g = args.in[11]; const float* ln1_b = args.in[12]; const float* w_xq = args.in[13]; const float* w_xk = args.in[14];
    const float* w_xv = args.in[15]; const float* w_xo = args.in[16]; const float* ln2_g = args.in[17]; const float* ln2_b = args.in[18]; const float* w_pq = args.in[19];
    const float* sub_keys = args.in[20]; const float* expert_u = args.in[21]; const float* expert_v = args.in[22]; const float* ln3_g = args.in[23]; const float* ln3_b = args.in[24];
    bf16* WIN = (bf16*)(ws + WS_WIN); bf16* WOUT = (bf16*)(ws + WS_WOUT); bf16* WXQ = (bf16*)(ws + WS_WXQ); bf16* WXKV = (bf16*)(ws + WS_WXKV); bf16* WXO = (bf16*)(ws + WS_WXO);
    bf16* WPQ = (bf16*)(ws + WS_WPQ); bf16* SKB = (bf16*)(ws + WS_SKB); bf16* WSPM = (bf16*)(ws + WS_WSPM); unsigned char* EU = ws + WS_EU; unsigned char* EV = ws + WS_EV;
    bf16* PROJ = (bf16*)(ws + WS_PROJ); bf16* XQ = (bf16*)(ws + WS_XQ); bf16* XO = (bf16*)(ws + WS_XO); bf16* PQ = (bf16*)(ws + WS_PQ);
    bf16* H0 = (bf16*)(ws + WS_B); bf16* H2 = (bf16*)(ws + WS_B); bf16* MIXIN = (bf16*)(ws + WS_C); bf16* H1 = (bf16*)(ws + WS_C);
    bf16* MEMB = (bf16*)(ws + WS_MEMB); bf16* XKV = (bf16*)(ws + WS_XKV); unsigned short* RIDX = (unsigned short*)(ws + WS_RIDX); float* RGATE = (float*)(ws + WS_RGATE);
    float* Z = args.out;

    for (int rep_ = 0; rep_ < (0 == DBG_REPEAT ? 2 : 1); ++rep_) if (IN(0)) {
        P0Args a{x, mem, ln_in_g, ln_in_b, w_in, w_sp, w_out, w_xq, w_xk, w_xv, w_xo, w_pq, sub_keys, expert_u, expert_v, WIN, WOUT, WXQ, WXKV, WXO, WPQ, SKB, WSPM, EU, EV, H0, MEMB};
        p0_prologue(C, a);
    }
    SEAM(0);
    for (int rep_ = 0; rep_ < (1 == DBG_REPEAT ? 2 : 1); ++rep_) if (IN(1)) {
        pg8::Gemm2 g{H0, WIN, MEMB, WXKV, DM}; pg8::Order2 S; S.init(T, NIN, TMEM, 2048, C.G, (int)blockIdx.x);
        pg8::EpiProj E{PROJ, NIN, XKV, 2048, QB_SCALE, 1024, 1536};
        pg8::gemm_phase<pg8::EpiProj, pg8::Order2, true, true>(C.lds, g, S, E);
    }
    SEAM(1);
    for (int rep_ = 0; rep_ < (2 == DBG_REPEAT ? 2 : 1); ++rep_) if (IN(2)) {
        for (int v = C.vcu; v < 1536; v += C.G) {
            if (v < 1024) chunk_attn_unit(C, PROJ, MIXIN, rel_bias, v >> 7, (v >> 4) & 7, v & 15);
            else { const int u = v - 1024; gmlp_unit(C, PROJ, MIXIN, WSPM, b_sp, gate_ln_g, gate_ln_b, u >> 2, u & 3); }
        }
    }
    SEAM(2);
    for (int rep_ = 0; rep_ < (3 == DBG_REPEAT ? 2 : 1); ++rep_) if (IN(3)) {
        pg8::Gemm2 g{MIXIN, WOUT, MIXIN, WOUT, DM}; pg8::Order2 S; S.init(T, DM, 0, 256, C.G, (int)blockIdx.x);
        pg8::EpiZ E{H0, Z, DM, DN_ALPHA, (DBG_MASK & 1) ? 0.f : 1.f};
        pg8::gemm_phase<pg8::EpiZ, pg8::Order2, true, true>(C.lds, g, S, E);
    }
    SEAM(3);
    for (int rep_ = 0; rep_ < (4 == DBG_REPEAT ? 2 : 1); ++rep_) if (IN(4)) ln_pass(C, Z, ln1_g, ln1_b, H1);
    SEAM(4);
    for (int rep_ = 0; rep_ < (5 == DBG_REPEAT ? 2 : 1); ++rep_) if (IN(5)) {
        pg8::Gemm2 g{H1, WXQ, H1, WXQ, DM}; pg8::Order2 S; S.init(T, DM, 0, 256, C.G, (int)blockIdx.x);
        pg8::EpiProj E{XQ, DM, XQ, DM, XQ_SCALE, 0, 1 << 30};
        pg8::gemm_phase<pg8::EpiProj, pg8::Order2, true, true>(C.lds, g, S, E);
    }
    SEAM(5);
    for (int rep_ = 0; rep_ < (6 == DBG_REPEAT ? 2 : 1); ++rep_) if (IN(6)) {
        for (int v = C.vcu; v < 512; v += C.G) xattn_unit(C, XQ, XKV, XO, v >> 6, (v >> 4) & 3, v & 15);
    }
    SEAM(6);
    for (int rep_ = 0; rep_ < (7 == DBG_REPEAT ? 2 : 1); ++rep_) if (IN(7)) {
        pg8::Gemm2 g{XO, WXO, XO, WXO, DM}; pg8::Order2 S; S.init(T, DM, 0, 256, C.G, (int)blockIdx.x);
        pg8::EpiZ E{H1, Z, DM, DN_ALPHA, (DBG_MASK & 2) ? 0.f : 1.f};
        pg8::gemm_phase<pg8::EpiZ, pg8::Order2, true, true>(C.lds, g, S, E);
    }
    SEAM(7);
    for (int rep_ = 0; rep_ < (8 == DBG_REPEAT ? 2 : 1); ++rep_) if (IN(8)) ln_pass(C, Z, ln2_g, ln2_b, H2);
    SEAM(8);
    for (int rep_ = 0; rep_ < (9 == DBG_REPEAT ? 2 : 1); ++rep_) if (IN(9)) {
        pg8::Gemm2 g{H2, WPQ, H2, WPQ, DM}; pg8::Order2 S; S.init(T, 2048, 0, 256, C.G, (int)blockIdx.x);
        pg8::EpiProj E{PQ, 2048, PQ, 2048, 1.f, 0, 0};
        pg8::gemm_phase<pg8::EpiProj, pg8::Order2, true, true>(C.lds, g, S, E);
    }
    SEAM(9);
    for (int rep_ = 0; rep_ < (10 == DBG_REPEAT ? 2 : 1); ++rep_) if (IN(10)) {
        for (int v = C.vcu; v < 1024; v += C.G) route_unit(C, PQ, SKB, RIDX, RGATE, v >> 3, v & 7, (float*)(ctl + 64));
    }
    SEAM(10);
    float* dbg = (float*)(ctl + 64);
    for (int rep_ = 0; rep_ < (11 == DBG_REPEAT ? 2 : 1); ++rep_) if (IN(11)) expert_phase(C, H2, EU, EV, RIDX, RGATE, ln3_g, ln3_b, args.out, dbg);
#if DBG_STAT
    if (IN(12)) { const float s = 1.f + 10.f * __hip_atomic_load(dbg, __ATOMIC_RELAXED, __HIP_MEMORY_SCOPE_AGENT);
        for (size_t i = (size_t)blockIdx.x * NTHREADS + C.tid; i < (size_t)T * DM; i += (size_t)C.G * NTHREADS) args.out[i] *= s; }
#endif
#undef IN
#undef SEAM
}

extern "C" void kernel_launch(void* const* d_in, const int* in_sizes, int n_in, void* d_out, int out_size, void* d_ws, size_t ws_size, hipStream_t stream) {
    static int grid = 0;
    if (grid == 0) {
        if (n_in != 25 || in_sizes[0] != T * DM || out_size != T * DM || ws_size < WS_END) {
            fprintf(stderr, "kernel_launch: unexpected problem (n_in %d, in0 %d, out %d, ws %zu); nothing launched\n", n_in, n_in > 0 ? in_sizes[0] : -1, out_size, ws_size); grid = -1; return; }
        int dev = 0, cus = 0, per_cu = 0;
        if (hipGetDevice(&dev) != hipSuccess || hipDeviceGetAttribute(&cus, hipDeviceAttributeMultiprocessorCount, dev) != hipSuccess) { grid = -1; return; }
        if (hipFuncSetAttribute((const void*)fwd_kernel, hipFuncAttributeMaxDynamicSharedMemorySize, LDS_BYTES) != hipSuccess) { fprintf(stderr, "kernel_launch: hipFuncSetAttribute failed\n"); grid = -1; return; }
        if (hipOccupancyMaxActiveBlocksPerMultiprocessor(&per_cu, (const void*)fwd_kernel, NTHREADS, LDS_BYTES) != hipSuccess || per_cu < 1)
            fprintf(stderr, "kernel_launch: note: occupancy query reports %d workgroups per CU\n", per_cu);
        (void)hipGetLastError();
        grid = cus;
    }
    if (grid < 0) return;
    if (hipMemsetAsync((char*)d_ws + WS_CTL, 0, CTL_ZERO_BYTES, stream) != hipSuccess) { fprintf(stderr, "kernel_launch: memset failed\n"); return; }
    Args a{};
    for (int i = 0; i < 25; ++i) a.in[i] = (const float*)d_in[i];
    a.out = (float*)d_out; a.ws = (unsigned char*)d_ws;
    constexpr int NL = MK_N_LAUNCHES;
    static_assert(NL == 1 || NL == 12, "MK_N_LAUNCHES: 1 (one launch) or 12 (one launch per phase)");
    for (int li = 0; li < (NL == 1 ? 1 : NPHASES); ++li) {
        a.ph_lo = (NL == 1) ? 0 : li; a.ph_hi = (NL == 1) ? NPHASES : li + 1; a.li = 0;
        hipLaunchKernelGGL(fwd_kernel, dim3(grid), dim3(NTHREADS), LDS_BYTES, stream, a);
        const hipError_t le = hipPeekAtLastError();
        if (le != hipSuccess) { fprintf(stderr, "kernel_launch: launch %d failed: %s\n", li, hipGetErrorName(le)); break; }
    }
}
```

```cpp
#include <hip/hip_runtime.h>
#include <cstdio>
#include <cstdint>

#ifndef DBG_MASK
#define DBG_MASK 0
#endif
#ifndef DBG_STAT
#define DBG_STAT 0
#endif
#ifndef DBG_REPEAT
#define DBG_REPEAT -1
#endif
#ifndef MK_N_LAUNCHES
#define MK_N_LAUNCHES 1
#endif

namespace pg8 {
#define PG8_LAS __attribute__((address_space(3)))
typedef unsigned short bf16_t;
typedef short bf16x8 __attribute__((ext_vector_type(8)));
typedef float f32x4 __attribute__((ext_vector_type(4)));
typedef unsigned u32x4 __attribute__((ext_vector_type(4)));
typedef unsigned u32x2 __attribute__((ext_vector_type(2)));
constexpr int BM = 256, BK = 64, HALF = 128, HTB = HALF * BK * 2  , STAGE_BYTES = 8 * HTB, NXCD = 8, WGM = 8;

__host__ __device__ __forceinline__ int lds_byte(int r, int c) { const int st = (r >> 4) * 2 + (c >> 5), rr = r & 15, cc = c & 31, ob = rr * 64 + cc * 2; return st * 1024 + (ob ^ (((ob >> 9) & 1) << 5)); }
__host__ __device__ __forceinline__ void stage_rc(int b, int& R, int& C) { const int st = b / 1024, sb = b % 1024, swz = sb ^ (((sb >> 9) & 1) << 5); R = (st >> 1) * 16 + swz / 64; C = (st & 1) * 32 + (swz % 64) / 2; }
__host__ __device__ __forceinline__ int perm32(int rho) { const int n = rho >> 4, i = rho & 15; return 8 * (i >> 2) + 4 * n + (i & 3); }

struct Unit { int pm, pn, g; };
struct Gemm2 { const bf16_t* A0; const bf16_t* B0; const bf16_t* A1; const bf16_t* B1; int K; };

struct Order2 {
    int nM0, nN0, nwg0, nM1, nN1, nwg1, G, c;
    __device__ void init(int M0, int N0, int M1, int N1, int G_, int c_) { nM0 = M0 / BM; nN0 = N0 / BM; nwg0 = nM0 * nN0; nM1 = M1 / BM; nN1 = N1 / BM; nwg1 = nM1 * nN1; G = G_; c = c_; }
    __device__ __forceinline__ bool next(int i, Unit& u) const {
        const int L = i * G + c; const bool in0 = L < nwg0;
        int wgid = in0 ? L : 0; { const int q = nwg0 / NXCD, r = nwg0 % NXCD, xcd = wgid % NXCD, off = wgid / NXCD; wgid = (xcd < r ? xcd * (q + 1) : r * (q + 1) + (xcd - r) * q) + off; }
        const int nig = WGM * nN0, gid = wgid / nig, fm = gid * WGM, gsz = (nM0 - fm) < WGM ? (nM0 - fm) : WGM;
        const int pm0 = fm + ((wgid % nig) % gsz), pn0 = (wgid % nig) / gsz;
        const int L1 = in0 ? 0 : L - nwg0, d1 = nM1 > 0 ? nM1 : 1;
        u.pm = in0 ? pm0 : (L1 % d1); u.pn = in0 ? pn0 : (L1 / d1); u.g = in0 ? 0 : 1;
        return in0 || (L - nwg0 < nwg1);
    }
    __device__ __forceinline__ void a_ready(const Unit&) const {}
    __device__ __forceinline__ void done(const Unit&) const {}
};

__device__ __forceinline__ unsigned cvt_pk_bf16(float lo, float hi) { unsigned r; asm volatile("v_cvt_pk_bf16_f32 %0, %1, %2" : "=v"(r) : "v"(lo), "v"(hi)); return r; }
typedef float f32x2 __attribute__((ext_vector_type(2)));
__device__ __forceinline__ f32x2 gelu_pk(f32x2 v) {
    const f32x2 av = __builtin_elementwise_abs(v), d = av * 0.2316418882f + 1.0f;
    f32x2 t; t.x = __builtin_amdgcn_rcpf(d.x); t.y = __builtin_amdgcn_rcpf(d.y);
    f32x2 q = t * 0.5307027145f + (-0.7265760135f); q = q * t + 0.7107068705f; q = q * t + (-0.142248368f); q = q * t + 0.127414796f; q = q * t;
    const f32x2 s = (v * v) * (-0.72134752044f);
    f32x2 e; e.x = __builtin_amdgcn_exp2f(s.x); e.y = __builtin_amdgcn_exp2f(s.y);
    const f32x2 m = v * (q * e), r = v - m;
    f32x2 o; o.x = v.x < 0.f ? m.x : r.x; o.y = v.y < 0.f ? m.y : r.y; return o;
}
__device__ __forceinline__ float gelu1(float v) { f32x2 x = {v, v}; return gelu_pk(x).x; }

struct EpiProj {
    static constexpr bool PERM = true, AFTER_DRAIN = false;
    bf16_t* O0; int ld0; bf16_t* O1; int ld1; float qscale; int gelu_cols, scale_cols;
    __device__ __forceinline__ void operator()(const f32x4 (&acc)[2][2][4][2], const Unit& u, int wr, int wc, int fr, int fq) const {
        const int row0 = u.pm * BM + wr * 64 + fr; const int colt = u.pn * BM;
        bf16_t* base = u.g ? O1 : O0; const int ldc = u.g ? ld1 : ld0;
        const int mode = u.g ? 0 : (colt < gelu_cols ? 1 : (colt < scale_cols ? 2 : 0));
        const float sc = mode == 2 ? qscale : 1.f;
        const int col0 = colt + wc * 32 + 8 * fq;
#pragma unroll
        for (int ai = 0; ai < 2; ++ai)
#pragma unroll
            for (int m = 0; m < 4; ++m) { bf16_t* rowp = base + (size_t)(row0 + ai * HALF + m * 16) * ldc + col0;
#pragma unroll
                for (int bj = 0; bj < 2; ++bj) { f32x4 v0 = acc[ai][bj][m][0], v1 = acc[ai][bj][m][1];
                    if (mode == 1) { f32x2 a = gelu_pk((f32x2){v0[0], v0[1]}), b = gelu_pk((f32x2){v0[2], v0[3]}), c = gelu_pk((f32x2){v1[0], v1[1]}), d = gelu_pk((f32x2){v1[2], v1[3]});
                        v0 = (f32x4){a.x, a.y, b.x, b.y}; v1 = (f32x4){c.x, c.y, d.x, d.y}; }
                    v0 = v0 * sc; v1 = v1 * sc; u32x4 w; w.x = cvt_pk_bf16(v0[0], v0[1]); w.y = cvt_pk_bf16(v0[2], v0[3]); w.z = cvt_pk_bf16(v1[0], v1[1]); w.w = cvt_pk_bf16(v1[2], v1[3]);
                    *(u32x4*)(rowp + bj * HALF) = w; } }
    }
};
struct EpiZ {
    static constexpr bool PERM = false, AFTER_DRAIN = false;
    const bf16_t* res; float* z; int ldc; float alpha; float accw;
    __device__ __forceinline__ void operator()(const f32x4 (&acc)[2][2][4][2], const Unit& u, int wr, int wc, int fr, int fq) const {
        const int col0 = u.pn * BM + wc * 32 + 4 * fq;
#pragma unroll
        for (int ai = 0; ai < 2; ++ai)
#pragma unroll
            for (int m = 0; m < 4; ++m) { const size_t off = (size_t)(u.pm * BM + ai * HALF + wr * 64 + m * 16 + fr) * ldc + col0;
#pragma unroll
                for (int bj = 0; bj < 2; ++bj)
#pragma unroll
                    for (int n = 0; n < 2; ++n) { const u32x2 rb = *(const u32x2*)(res + off + bj * HALF + n * 16);
                        f32x4 r; r[0] = __uint_as_float(rb.x << 16); r[1] = __uint_as_float(rb.x & 0xffff0000u); r[2] = __uint_as_float(rb.y << 16); r[3] = __uint_as_float(rb.y & 0xffff0000u);
                        *(f32x4*)(z + off + bj * HALF + n * 16) = r * alpha + acc[ai][bj][m][n] * accw; } }
    }
};

template <class Epi, class Sched, bool ALIGN_EPI = false, bool SP2 = false>
__device__ __forceinline__ void gemm_phase(PG8_LAS unsigned char* lds, const Gemm2 g, const Sched& S, const Epi& E) {
    const int tid = threadIdx.x, wid = __builtin_amdgcn_readfirstlane(tid >> 6), lane = tid & 63, wr = wid >> 2, wc = wid & 3, fr = lane & 15, fq = lane >> 4;
    const int K = g.K, nt = K / BK;
    unsigned voffA[2], voffB[2];
#pragma unroll
    for (int i = 0; i < 2; ++i) { int R, C; stage_rc(tid * 16 + i * 8192, R, C); const int Rb = Epi::PERM ? ((R & ~31) + perm32(R & 31)) : R;
        voffA[i] = (unsigned)(R * K + C) * 2u; voffB[i] = (unsigned)(Rb * K + C) * 2u; }
    const size_t kstep = (size_t)(BK * 2);
    const size_t hstep = (size_t)HALF * K * 2;
    const size_t tstep = 2 * hstep;
    const unsigned ldsw = (unsigned)wid * 1024u;
    const int aoff = lds_byte(wr * 64 + fr, fq * 8), boff = lds_byte(wc * 32 + fr, fq * 8);
#define PG8_SA(b, h) (((b) * 2 + (h)) * HTB)
#define PG8_SB(b, h) ((4 + (b) * 2 + (h)) * HTB)
#define PG8_STAGE(bufoff, gbase, voff) do { _Pragma("unroll") for (int _i = 0; _i < 2; ++_i) \
        __builtin_amdgcn_global_load_lds((const unsigned*)((const char*)(gbase) + (voff)[_i]), (PG8_LAS unsigned*)(lds + (bufoff) + ldsw + _i * 8192), 16, 0, 0); } while (0)
#define PG8_LDA(dst, b, h) do { _Pragma("unroll") for (int m = 0; m < 4; ++m) _Pragma("unroll") for (int k = 0; k < 2; ++k) dst[m][k] = *(const PG8_LAS bf16x8*)(lds + PG8_SA(b, h) + aoff + m * 2048 + k * 1024); } while (0)
#define PG8_LDB(dst, b, h) do { _Pragma("unroll") for (int n = 0; n < 2; ++n) _Pragma("unroll") for (int k = 0; k < 2; ++k) dst[n][k] = *(const PG8_LAS bf16x8*)(lds + PG8_SB(b, h) + boff + n * 2048 + k * 1024); } while (0)
#define PG8_MMA(ai, bj, At, Bt) do { __builtin_amdgcn_s_setprio(1); _Pragma("unroll") for (int m = 0; m < 4; ++m) _Pragma("unroll") for (int n = 0; n < 2; ++n) _Pragma("unroll") for (int k = 0; k < 2; ++k) \
        acc[ai][bj][m][n] = __builtin_amdgcn_mfma_f32_16x16x32_bf16(Bt[n][k], At[m][k], acc[ai][bj][m][n], 0, 0, 0); __builtin_amdgcn_s_setprio(0); } while (0)
#define PG8_WAIT_V(n) asm volatile("s_waitcnt vmcnt(" #n ")" ::: "memory")
#define PG8_WAIT_L(n) asm volatile("s_waitcnt lgkmcnt(" #n ")" ::: "memory")
#define PG8_BAR __builtin_amdgcn_s_barrier()
#define PG8_SCHED __builtin_amdgcn_sched_barrier(0)
    Unit cur, nxt; int ui = 0;
    if (!S.next(0, cur)) return;
    f32x4 acc[2][2][4][2];
#pragma unroll
    for (int a = 0; a < 2; ++a)
#pragma unroll
        for (int b = 0; b < 2; ++b)
#pragma unroll
            for (int m = 0; m < 4; ++m)
#pragma unroll
                for (int n = 0; n < 2; ++n) acc[a][b][m][n] = (f32x4){0.f, 0.f, 0.f, 0.f};
    bf16x8 At[4][2], B0[2][2], B1[2][2];
    const char* cA = (const char*)(cur.g ? g.A1 : g.A0) + (size_t)cur.pm * tstep; const char* cB = (const char*)(cur.g ? g.B1 : g.B0) + (size_t)cur.pn * tstep;
    S.a_ready(cur);
    if constexpr (SP2) {
        PG8_STAGE(PG8_SB(0, 0), cB, voffB); PG8_STAGE(PG8_SB(0, 1), cB + hstep, voffB); PG8_STAGE(PG8_SA(0, 0), cA, voffA); PG8_STAGE(PG8_SA(0, 1), cA + hstep, voffA);
        if (wr == 1) PG8_BAR;
        PG8_WAIT_V(2); PG8_BAR;
        PG8_STAGE(PG8_SB(1, 0), cB + kstep, voffB); PG8_STAGE(PG8_SA(1, 0), cA + kstep, voffA); PG8_STAGE(PG8_SB(1, 1), cB + hstep + kstep, voffB);
        PG8_WAIT_V(6); PG8_BAR;
    } else {
        PG8_STAGE(PG8_SB(0, 0), cB, voffB); PG8_STAGE(PG8_SA(0, 0), cA, voffA); PG8_STAGE(PG8_SB(0, 1), cB + hstep, voffB); PG8_STAGE(PG8_SA(0, 1), cA + hstep, voffA);
        if (wr == 1) PG8_BAR;
        PG8_WAIT_V(4); PG8_BAR;
        PG8_STAGE(PG8_SB(1, 0), cB + kstep, voffB); PG8_STAGE(PG8_SA(1, 0), cA + kstep, voffA); PG8_STAGE(PG8_SB(1, 1), cB + hstep + kstep, voffB);
        PG8_WAIT_V(6); PG8_BAR;
    }
    for (;;) {
        const bool has_next = S.next(ui + 1, nxt);
        const char* nA = has_next ? (const char*)(nxt.g ? g.A1 : g.A0) + (size_t)nxt.pm * tstep : cA; const char* nB = has_next ? (const char*)(nxt.g ? g.B1 : g.B0) + (size_t)nxt.pn * tstep : cB;
        for (int t = 0; t < nt; t += 2) {
            const bool last = (t == nt - 2);
            const char* a1 = cA + (size_t)(t + 1) * kstep;
            const char* a2 = last ? nA : cA + (size_t)(t + 2) * kstep; const char* b2 = last ? nB : cB + (size_t)(t + 2) * kstep;
            const char* a3 = a2 + kstep; const char* b3 = b2 + kstep;
            if (last && has_next) S.a_ready(nxt);
            if constexpr (SP2) {
            PG8_LDB(B0, 0, 0); PG8_LDB(B1, 0, 1); PG8_SCHED; PG8_LDA(At, 0, 0); PG8_STAGE(PG8_SA(1, 1), a1 + hstep, voffA);
            PG8_WAIT_V(8); PG8_WAIT_L(0); PG8_BAR; PG8_MMA(0, 0, At, B0); PG8_MMA(0, 1, At, B1); PG8_BAR; PG8_SCHED;
            PG8_LDA(At, 0, 1); PG8_STAGE(PG8_SB(0, 0), b2, voffB); PG8_STAGE(PG8_SB(0, 1), b2 + hstep, voffB); PG8_STAGE(PG8_SA(0, 0), a2, voffA);
            PG8_WAIT_V(8); PG8_WAIT_L(0); PG8_BAR; PG8_MMA(1, 0, At, B0); PG8_MMA(1, 1, At, B1); PG8_BAR; PG8_SCHED;
            PG8_LDB(B0, 1, 0); PG8_LDB(B1, 1, 1); PG8_SCHED; PG8_LDA(At, 1, 0); PG8_STAGE(PG8_SA(0, 1), a2 + hstep, voffA);
            PG8_WAIT_V(8); PG8_WAIT_L(0); PG8_BAR; PG8_MMA(0, 0, At, B0); PG8_MMA(0, 1, At, B1); PG8_BAR; PG8_SCHED;
            PG8_LDA(At, 1, 1); PG8_STAGE(PG8_SB(1, 0), b3, voffB); PG8_STAGE(PG8_SB(1, 1), b3 + hstep, voffB); PG8_STAGE(PG8_SA(1, 0), a3, voffA);
            PG8_WAIT_V(8); PG8_WAIT_L(0); PG8_BAR; PG8_MMA(1, 0, At, B0); PG8_MMA(1, 1, At, B1); PG8_BAR; PG8_SCHED;
            } else {
            PG8_LDB(B0, 0, 0); PG8_SCHED; PG8_LDA(At, 0, 0); PG8_STAGE(PG8_SA(1, 1), a1 + hstep, voffA);
            PG8_WAIT_L(8); PG8_BAR; PG8_WAIT_L(0); PG8_MMA(0, 0, At, B0); PG8_BAR; PG8_SCHED;
            PG8_LDB(B1, 0, 1); PG8_STAGE(PG8_SB(0, 0), b2, voffB);
            PG8_BAR; PG8_WAIT_L(0); PG8_MMA(0, 1, At, B1); PG8_BAR;
            PG8_LDA(At, 0, 1); PG8_STAGE(PG8_SA(0, 0), a2, voffA);
            PG8_BAR; PG8_WAIT_L(0); PG8_MMA(1, 0, At, B0); PG8_BAR; PG8_SCHED;
            PG8_STAGE(PG8_SB(0, 1), b2 + hstep, voffB);
            PG8_WAIT_V(6); PG8_BAR; PG8_MMA(1, 1, At, B1); PG8_BAR;
            PG8_LDB(B0, 1, 0); PG8_SCHED; PG8_LDA(At, 1, 0); PG8_STAGE(PG8_SA(0, 1), a2 + hstep, voffA);
            PG8_WAIT_L(8); PG8_BAR; PG8_WAIT_L(0); PG8_MMA(0, 0, At, B0); PG8_BAR; PG8_SCHED;
            PG8_LDB(B1, 1, 1); PG8_STAGE(PG8_SB(1, 0), b3, voffB);
            PG8_BAR; PG8_WAIT_L(0); PG8_MMA(0, 1, At, B1); PG8_BAR;
            PG8_LDA(At, 1, 1); PG8_STAGE(PG8_SA(1, 0), a3, voffA);
            PG8_BAR; PG8_WAIT_L(0); PG8_MMA(1, 0, At, B0); PG8_BAR; PG8_SCHED;
            PG8_STAGE(PG8_SB(1, 1), b3 + hstep, voffB);
            PG8_WAIT_V(6); PG8_BAR; PG8_MMA(1, 1, At, B1); PG8_BAR;
            }
        }
        if constexpr (ALIGN_EPI) { if (wr == 0) PG8_BAR; }
        if constexpr (!Epi::AFTER_DRAIN) { E(acc, cur, wr, wc, fr, fq); S.done(cur); }
        if (!has_next) break;
#pragma unroll
        for (int a = 0; a < 2; ++a)
#pragma unroll
            for (int b = 0; b < 2; ++b)
#pragma unroll
                for (int m = 0; m < 4; ++m)
#pragma unroll
                    for (int n = 0; n < 2; ++n) acc[a][b][m][n] = (f32x4){0.f, 0.f, 0.f, 0.f};
        cur = nxt; cA = nA; cB = nB; ++ui;
        if constexpr (ALIGN_EPI) { if (wr == 1) PG8_BAR; }
    }
    PG8_WAIT_V(0);
    if constexpr (!ALIGN_EPI) { if (wr == 0) PG8_BAR; }
    PG8_BAR;
    if constexpr (Epi::AFTER_DRAIN) { E.fused(acc, cur, wr, wc, fr, fq, lds, wid, lane); S.done(cur); }
#undef PG8_SA
#undef PG8_SB
#undef PG8_STAGE
#undef PG8_LDA
#undef PG8_LDB
#undef PG8_MMA
#undef PG8_WAIT_V
#undef PG8_WAIT_L
#undef PG8_BAR
#undef PG8_SCHED
}
}

#define GAS __attribute__((address_space(1)))
#define LAS __attribute__((address_space(3)))
typedef unsigned short bf16;
typedef unsigned v4u __attribute__((ext_vector_type(4)));
typedef float f32x4 __attribute__((ext_vector_type(4)));
typedef short bf16x8 __attribute__((ext_vector_type(8)));
typedef GAS unsigned gu32;
typedef GAS unsigned long long gu64;
#define RLX_AGENT __ATOMIC_RELAXED, __HIP_MEMORY_SCOPE_AGENT
#define LDS_WAIT() asm volatile("s_waitcnt lgkmcnt(0)" ::: "memory")
#define VM_WAIT() asm volatile("s_waitcnt vmcnt(0)" ::: "memory")
__device__ __forceinline__ unsigned long long rt() { return __builtin_amdgcn_s_memrealtime(); }
__device__ __forceinline__ unsigned f2bf(float f) { unsigned u = __builtin_bit_cast(unsigned, f); return (u + 0x7fffu + ((u >> 16) & 1u)) >> 16; }
__device__ __forceinline__ unsigned pk2(float lo, float hi) { return f2bf(lo) | (f2bf(hi) << 16); }

#define XB_TMO      128
#define XB_XCNT(j)  (256  + 64 * (j))
#define XB_XSUB(j)  (1280 + 64 * (j))
#define XB_XGEN(j)  (2304 + 64 * (j))
#define XB_TOP      3328
#define XB_TOPGEN   3392
#define XCD_BAR_WORDS 3456
#define XB_SPIN_CAP (1u << 18)

__device__ __forceinline__ unsigned xb_ld(unsigned* p)              { return __hip_atomic_load(p, __ATOMIC_RELAXED, __HIP_MEMORY_SCOPE_AGENT); }
__device__ __forceinline__ unsigned xb_add(unsigned* p, unsigned v) { return __hip_atomic_fetch_add(p, v, __ATOMIC_RELAXED, __HIP_MEMORY_SCOPE_AGENT); }
__device__ __forceinline__ unsigned xb_xcc_id() { return (unsigned)__builtin_amdgcn_s_getreg((3 << 11) | 20) & 0xFu; }
#define XB_SPIN(cond, bar) do { unsigned _sp = 0; while (cond) { __builtin_amdgcn_s_sleep(1); \
    if ((++_sp & 255u) == 0u) { if (xb_ld(&(bar)[XB_TMO])) break; if (_sp > XB_SPIN_CAP) { atomicAdd(&(bar)[XB_TMO], 1u); break; } } } } while (0)

struct XcdBarrier {
    unsigned* bar; unsigned x;
    volatile LAS unsigned* st;
};

__device__ __forceinline__ XcdBarrier xcd_barrier_post(unsigned* bar, volatile LAS unsigned* st) {
    XcdBarrier b; b.bar = bar; b.x = xb_xcc_id(); b.st = st;
    if (threadIdx.x == 0) (void)xb_add(&bar[XB_XCNT(b.x)], 1u);
    return b;
}
__device__ __forceinline__ void xcd_barrier_complete(unsigned* bar, unsigned x, unsigned& nloc, unsigned& nx) {
    const unsigned G = gridDim.x * gridDim.y * gridDim.z;
    unsigned sum, cnt, mine, sp = 0u;
    for (;;) {
        sum = 0u; cnt = 0u; mine = 0u;
#pragma unroll
        for (unsigned j = 0; j < 16; ++j) { const unsigned c = xb_ld(&bar[XB_XCNT(j)]); sum += c; cnt += (c > 0u) ? 1u : 0u; mine = (j == x) ? c : mine; }
        if (sum == G) break;
        __builtin_amdgcn_s_sleep(1);
        if ((++sp & 255u) == 0u) { if (xb_ld(&bar[XB_TMO])) break; if (sp > XB_SPIN_CAP) { atomicAdd(&bar[XB_TMO], 1u); break; } }
    }
    nloc = mine > 0u ? mine : 1u; nx = cnt > 0u ? cnt : 1u;
}

__device__ __forceinline__ void xcd_barrier(const XcdBarrier& b) {
    asm volatile("s_waitcnt vmcnt(0)" ::: "memory");
    __syncthreads();
    if (threadIdx.x == 0) {
        unsigned* bar = b.bar;
        __builtin_amdgcn_s_waitcnt(0);
        unsigned nloc = b.st[0], nx = b.st[1];
        if (nloc == 0u) { xcd_barrier_complete(bar, b.x, nloc, nx); b.st[0] = nloc; b.st[1] = nx; }
        const unsigned old = xb_add(&bar[XB_XSUB(b.x)], 1u);
        const unsigned gen = old / nloc;
        if (old + 1u == (gen + 1u) * nloc) {
            __builtin_amdgcn_fence(__ATOMIC_RELEASE, "agent");
            asm volatile("s_waitcnt vmcnt(0)" ::: "memory");
            const unsigned og = xb_add(&bar[XB_TOP], 1u);
            const unsigned tg = og / nx;
            if (og + 1u == (tg + 1u) * nx) xb_add(&bar[XB_TOPGEN], 1u);
            else XB_SPIN(xb_ld(&bar[XB_TOPGEN]) == tg, bar);
            __builtin_amdgcn_fence(__ATOMIC_ACQUIRE, "agent");
            xb_add(&bar[XB_XGEN(b.x)], 1u);
            asm volatile("s_waitcnt vmcnt(0)" ::: "memory");
        } else {
            XB_SPIN(xb_ld(&bar[XB_XGEN(b.x)]) == gen, bar);
            __builtin_amdgcn_fence(__ATOMIC_ACQUIRE, "agent");
            asm volatile("s_waitcnt vmcnt(0)" ::: "memory");
        }
    }
    __syncthreads();
}

constexpr int NWAVES = 8, NTHREADS = 512;
constexpr int BATCH = 8, SEQ = 2048, DM = 1024, T = BATCH * SEQ;
constexpr int NIN = 2560, MEMLEN = 256, TMEM = BATCH * MEMLEN;
constexpr int NEXP = 16384;
constexpr float LN_EPS = 1e-5f;
constexpr float DN_ALPHA = 1.189207115002721f;
constexpr float LOG2E = 1.4426950408889634f;
constexpr float QB_SCALE = 0.125f * LOG2E;
constexpr float XQ_SCALE = 0.0625f * LOG2E;
constexpr float EU_SCALE = 256.f, EV_SCALE = 16.f;

constexpr size_t MiB = 1u << 20;
constexpr size_t WS_CTL = 0, CTL_ZERO_BYTES = 1 * MiB;
constexpr size_t WS_WIN = 1 * MiB;
constexpr size_t WS_WOUT = 6 * MiB;
constexpr size_t WS_WXQ = 8 * MiB;
constexpr size_t WS_WXKV = 10 * MiB;
constexpr size_t WS_WXO = 14 * MiB;
constexpr size_t WS_WPQ = 16 * MiB;
constexpr size_t WS_SKB = 20 * MiB;
constexpr size_t WS_WSPM = 20 * MiB + 512 * 1024;
constexpr size_t WS_EU = 21 * MiB;
constexpr size_t WS_EV = 37 * MiB;
constexpr size_t WS_A = 85 * MiB;
constexpr size_t WS_PROJ = WS_A, WS_XQ = WS_A, WS_XO = WS_A + 32 * MiB, WS_PQ = WS_A;
constexpr size_t WS_B = 165 * MiB;
constexpr size_t WS_C = 197 * MiB;
constexpr size_t WS_MEMB = 229 * MiB;
constexpr size_t WS_XKV = 233 * MiB;
constexpr size_t WS_RIDX = 241 * MiB;
constexpr size_t WS_RGATE = 245 * MiB;
constexpr size_t WS_END = 253 * MiB;
constexpr int CW_BAR = 4096;

constexpr int SCRATCH_BYTES = 139264;
constexpr int LDSCTL_OFF = SCRATCH_BYTES;
constexpr int LDS_BYTES = SCRATCH_BYTES + 1024;

typedef short s16x4 __attribute__((ext_vector_type(4)));
typedef unsigned u32x2v __attribute__((ext_vector_type(2)));
typedef __bf16 v2bf16 __attribute__((ext_vector_type(2)));

struct Ctx { LAS unsigned char* lds; int tid, lane, wave, vcu, G; };

__device__ __forceinline__ float bf_lo(unsigned u) { return __uint_as_float(u << 16); }
__device__ __forceinline__ float bf_hi(unsigned u) { return __uint_as_float(u & 0xffff0000u); }
__device__ __forceinline__ float wave_sum(float v) {
#pragma unroll
    for (int o = 1; o < 64; o <<= 1) v += __shfl_xor(v, o);
    return v;
}
__device__ __forceinline__ bf16x8 pack8(f32x4 a, f32x4 b) {
    v4u w; w.x = pg8::cvt_pk_bf16(a[0], a[1]); w.y = pg8::cvt_pk_bf16(a[2], a[3]); w.z = pg8::cvt_pk_bf16(b[0], b[1]); w.w = pg8::cvt_pk_bf16(b[2], b[3]);
    return __builtin_bit_cast(bf16x8, w);
}
__device__ __forceinline__ s16x4 tr4(LAS unsigned char* p) { return __builtin_amdgcn_ds_read_tr16_b64_v4i16((LAS s16x4*)p); }
__device__ __forceinline__ bf16x8 cat8(s16x4 lo, s16x4 hi) { return (bf16x8){lo[0], lo[1], lo[2], lo[3], hi[0], hi[1], hi[2], hi[3]}; }
#define MFMA16(a, b, c) __builtin_amdgcn_mfma_f32_16x16x32_bf16((a), (b), (c), 0, 0, 0)

__device__ __forceinline__ void p0_transpose_item(const float* W, int K, int N, bf16* WT, int row_off, LAS float* scr, int item, int lane) {
    const int nblk = N / 32, kb = item / nblk, nb = item % nblk, k0 = 64 * kb, n0 = 32 * nb;
#pragma unroll 8
    for (int i = 0; i < 32; ++i) { const int kk = 2 * i + (lane >> 5); scr[kk * 33 + (lane & 31)] = W[(size_t)(k0 + kk) * N + n0 + (lane & 31)]; }
    LDS_WAIT(); asm volatile("" ::: "memory");
    const int c = lane & 7;
#pragma unroll
    for (int j = 0; j < 4; ++j) { const int n = (lane >> 3) + 8 * j; const LAS float* s = scr + (8 * c) * 33 + n;
        v4u o; o.x = pk2(s[0 * 33], s[1 * 33]); o.y = pk2(s[2 * 33], s[3 * 33]); o.z = pk2(s[4 * 33], s[5 * 33]); o.w = pk2(s[6 * 33], s[7 * 33]);
        *(GAS v4u*)(WT + (size_t)(row_off + n0 + n) * K + k0 + 8 * c) = o; }
    LDS_WAIT(); asm volatile("" ::: "memory");
}
__device__ __forceinline__ void cvt_f32_bf16(const float* src, bf16* dst, size_t n_elems, int gw, int NGW, int lane) {
    const size_t nitems = n_elems / 512;
#pragma unroll 4
    for (size_t it = gw; it < nitems; it += NGW) {
        const GAS f32x4* s = (const GAS f32x4*)(src + it * 512 + lane * 8);
        const f32x4 a = s[0], b = s[1];
        v4u o; o.x = pk2(a[0], a[1]); o.y = pk2(a[2], a[3]); o.z = pk2(b[0], b[1]); o.w = pk2(b[2], b[3]);
        *(GAS v4u*)(dst + it * 512 + lane * 8) = o;
    }
}
__device__ __forceinline__ void cvt_f32_fp8_rows(const float* src, unsigned char* dst, int nrows, float scale, int gw, int NGW, int lane) {
#pragma unroll 2
    for (int r = gw; r < nrows; r += NGW) {
        const GAS f32x4* s = (const GAS f32x4*)(src + (size_t)r * DM + lane * 16);
        const f32x4 a = s[0] * scale, b = s[1] * scale, c = s[2] * scale, d = s[3] * scale;
        v4u o;
        o.x = (unsigned)__builtin_amdgcn_cvt_pk_fp8_f32(a[2], a[3], __builtin_amdgcn_cvt_pk_fp8_f32(a[0], a[1], 0, false), true);
        o.y = (unsigned)__builtin_amdgcn_cvt_pk_fp8_f32(b[2], b[3], __builtin_amdgcn_cvt_pk_fp8_f32(b[0], b[1], 0, false), true);
        o.z = (unsigned)__builtin_amdgcn_cvt_pk_fp8_f32(c[2], c[3], __builtin_amdgcn_cvt_pk_fp8_f32(c[0], c[1], 0, false), true);
        o.w = (unsigned)__builtin_amdgcn_cvt_pk_fp8_f32(d[2], d[3], __builtin_amdgcn_cvt_pk_fp8_f32(d[0], d[1], 0, false), true);
        *(GAS v4u*)(dst + (size_t)(lane >> 3) * ((size_t)NEXP * 128) + (size_t)r * 128 + (lane & 7) * 16) = o;
    }
}
__device__ __forceinline__ void ln_row_to_bf16(const float* xrow, const float* gam, const float* bet, bf16* orow, int lane) {
    const GAS f32x4* xr = (const GAS f32x4*)xrow + lane;
    f32x4 v[4]; float s = 0.f;
#pragma unroll
    for (int j = 0; j < 4; ++j) { v[j] = xr[64 * j]; s += (v[j][0] + v[j][1]) + (v[j][2] + v[j][3]); }
    const float mean = wave_sum(s) * (1.f / DM); float s2 = 0.f;
#pragma unroll
    for (int j = 0; j < 4; ++j) { v[j] = v[j] - mean; s2 += (v[j][0] * v[j][0] + v[j][1] * v[j][1]) + (v[j][2] * v[j][2] + v[j][3] * v[j][3]); }
    const float rstd = 1.f / sqrtf(wave_sum(s2) * (1.f / DM) + LN_EPS);
    GAS unsigned long long* o8 = (GAS unsigned long long*)orow + lane;
#pragma unroll
    for (int j = 0; j < 4; ++j) { const f32x4 gg = *((const GAS f32x4*)gam + lane + 64 * j), bb = *((const GAS f32x4*)bet + lane + 64 * j);
        const f32x4 y = v[j] * rstd * gg + bb;
        o8[64 * j] = (unsigned long long)pk2(y[0], y[1]) | ((unsigned long long)pk2(y[2], y[3]) << 32); }
}
struct P0Args { const float *x, *mem, *ln_g, *ln_b, *w_in, *w_sp, *w_out, *w_xq, *w_xk, *w_xv, *w_xo, *w_pq, *sub_keys, *eu, *ev;
                bf16 *WIN, *WOUT, *WXQ, *WXKV, *WXO, *WPQ, *SKB, *WSPM; unsigned char *EU, *EV; bf16 *H0, *MEMB; };
__device__ __forceinline__ void p0_prologue(const Ctx& C, const P0Args& a) {
    LAS float* scr = (LAS float*)(C.lds + C.wave * 16384);
    const int gw = C.vcu * NWAVES + C.wave, NGW = C.G * NWAVES, lane = C.lane;
    constexpr int I_IN = 16 * (NIN / 32), I_SQ = 16 * (DM / 32), I_PQ = 16 * (2048 / 32);
    constexpr int NITEMS = I_IN + 5 * I_SQ + I_PQ;
    for (int it = gw; it < NITEMS; it += NGW) {
        int r = it;
        if (r < I_IN) { p0_transpose_item(a.w_in, DM, NIN, a.WIN, 0, scr, r, lane); continue; } r -= I_IN;
        if (r < I_SQ) { p0_transpose_item(a.w_out, DM, DM, a.WOUT, 0, scr, r, lane); continue; } r -= I_SQ;
        if (r < I_SQ) { p0_transpose_item(a.w_xq, DM, DM, a.WXQ, 0, scr, r, lane); continue; } r -= I_SQ;
        if (r < I_SQ) { p0_transpose_item(a.w_xk, DM, DM, a.WXKV, 0, scr, r, lane); continue; } r -= I_SQ;
        if (r < I_SQ) { p0_transpose_item(a.w_xv, DM, DM, a.WXKV, DM, scr, r, lane); continue; } r -= I_SQ;
        if (r < I_SQ) { p0_transpose_item(a.w_xo, DM, DM, a.WXO, 0, scr, r, lane); continue; } r -= I_SQ;
        p0_transpose_item(a.w_pq, DM, 2048, a.WPQ, 0, scr, r, lane);
    }
    for (int m = gw; m < T; m += NGW) ln_row_to_bf16(a.x + (size_t)m * DM, a.ln_g, a.ln_b, a.H0 + (size_t)m * DM, lane);
    cvt_f32_bf16(a.mem, a.MEMB, (size_t)TMEM * DM, gw, NGW, lane);
    cvt_f32_bf16(a.sub_keys, a.SKB, (size_t)16 * 128 * 128, gw, NGW, lane);
    for (int it = gw; it < 4 * 128 * 128 / 512; it += NGW) {
        const int e0 = it * 512 + lane * 8, i = (e0 >> 7) & 127, j = e0 & 127; const bool keep = !(i < 64 && j >= 64);
        const GAS f32x4* s = (const GAS f32x4*)(a.w_sp + e0); const f32x4 p = s[0], q = s[1];
        v4u o; o.x = pk2(p[0], p[1]); o.y = pk2(p[2], p[3]); o.z = pk2(q[0], q[1]); o.w = pk2(q[2], q[3]);
        if (!keep) o = (v4u){0u, 0u, 0u, 0u};
        *(GAS v4u*)(a.WSPM + e0) = o;
    }
    cvt_f32_fp8_rows(a.eu, a.EU, NEXP, EU_SCALE, gw, NGW, lane);
    cvt_f32_fp8_rows(a.ev, a.EV, NEXP, EV_SCALE, gw, NGW, lane);
}
__device__ __forceinline__ void ln_pass(const Ctx& C, const float* Z, const float* gam, const float* bet, bf16* H) {
    const int gw = C.vcu * NWAVES + C.wave, NGW = C.G * NWAVES;
    for (int m = gw; m < T; m += NGW) ln_row_to_bf16(Z + (size_t)m * DM, gam, bet, H + (size_t)m * DM, C.lane);
}

__device__ __forceinline__ void chunk_attn_unit(const Ctx& C, const bf16* PROJ, bf16* MIXIN, const float* rel_bias, int b, int h, int cp) {
    LAS unsigned char* lds = C.lds;
    LAS float* rb = (LAS float*)(lds + 18432);
    const int lane = C.lane, w = C.wave, g = lane >> 4, li = lane & 15;
    __syncthreads();
    for (int i = C.tid; i < 257; i += NTHREADS) rb[i] = rel_bias[h * 257 + i] * LOG2E;
    const int c = 2 * cp + (w >> 2), qt = w & 3, qi = 16 * qt + li;
    const size_t tok = (size_t)b * SEQ + 64 * c + qi;
    bf16x8 qf[2];
#pragma unroll
    for (int ks = 0; ks < 2; ++ks) qf[ks] = *(const GAS bf16x8*)(PROJ + tok * NIN + 1024 + h * 64 + 32 * ks + 8 * g);
    float m = -1e30f, l = 0.f; f32x4 O[4];
#pragma unroll
    for (int dt = 0; dt < 4; ++dt) O[dt] = (f32x4){0.f, 0.f, 0.f, 0.f};
    for (int kc = 2 * cp - 8; kc <= 2 * cp + 1; ++kc) {
        if (kc < 0) continue;
        __syncthreads();
        { const int row = C.tid >> 3, ch = C.tid & 7;
          const bf16* src = PROJ + ((size_t)b * SEQ + 64 * kc + row) * NIN + 1536 + h * 64 + ch * 8;
          const v4u kv = *(const GAS v4u*)src, vv = *(const GAS v4u*)(src + 512);
          *(LAS v4u*)(lds + row * 144 + ch * 16) = kv; *(LAS v4u*)(lds + 9216 + row * 144 + ch * 16) = vv; }
        __syncthreads();
        if (kc >= c - 8 && kc <= c) {
            f32x4 s[4];
#pragma unroll
            for (int mt = 0; mt < 4; ++mt) { s[mt] = (f32x4){0.f, 0.f, 0.f, 0.f};
#pragma unroll
                for (int ks = 0; ks < 2; ++ks) { const bf16x8 a = *(const LAS bf16x8*)(lds + (16 * mt + li) * 144 + (32 * ks + 8 * g) * 2); s[mt] = MFMA16(a, qf[ks], s[mt]); } }
            const int dch = c - kc;
            if (dch >= 3) { const float bc = rb[256];
#pragma unroll
                for (int mt = 0; mt < 4; ++mt) s[mt] = s[mt] + bc;
            } else {
#pragma unroll
                for (int mt = 0; mt < 4; ++mt)
#pragma unroll
                    for (int r = 0; r < 4; ++r) { const int kj = 16 * mt + 4 * g + r; int dist = 64 * dch + qi - kj; dist = dist > 128 ? 128 : dist; s[mt][r] += rb[dist + 128]; }
            }
            float mx = -1e30f;
#pragma unroll
            for (int mt = 0; mt < 4; ++mt) mx = fmaxf(mx, fmaxf(fmaxf(s[mt][0], s[mt][1]), fmaxf(s[mt][2], s[mt][3])));
            mx = fmaxf(mx, __shfl_xor(mx, 16)); mx = fmaxf(mx, __shfl_xor(mx, 32));
            const float mn = fmaxf(m, mx), alpha = __builtin_amdgcn_exp2f(m - mn); m = mn;
            float rs = 0.f;
#pragma unroll
            for (int mt = 0; mt < 4; ++mt)
#pragma unroll
                for (int r = 0; r < 4; ++r) { s[mt][r] = __builtin_amdgcn_exp2f(s[mt][r] - mn); rs += s[mt][r]; }
            rs += __shfl_xor(rs, 16); rs += __shfl_xor(rs, 32);
            l = l * alpha + rs;
#pragma unroll
            for (int dt = 0; dt < 4; ++dt) O[dt] = O[dt] * alpha;
            bf16x8 pf[2]; pf[0] = pack8(s[0], s[1]); pf[1] = pack8(s[2], s[3]);
#pragma unroll
            for (int dt = 0; dt < 4; ++dt)
#pragma unroll
                for (int kk = 0; kk < 2; ++kk) {
                    LAS unsigned char* p = lds + 9216 + (32 * kk + 4 * g + (li >> 2)) * 144 + (16 * dt + 4 * (li & 3)) * 2;
                    const s16x4 lo = tr4(p), hi = tr4(p + 16 * 144);
                    O[dt] = MFMA16(cat8(lo, hi), pf[kk], O[dt]);
                }
        }
    }
    const float il = 1.f / l;
#pragma unroll
    for (int dt = 0; dt < 4; ++dt) { const f32x4 o = O[dt] * il; u32x2v wv; wv.x = pg8::cvt_pk_bf16(o[0], o[1]); wv.y = pg8::cvt_pk_bf16(o[2], o[3]);
        *(GAS u32x2v*)(MIXIN + tok * DM + 512 + 64 * h + 16 * dt + 4 * g) = wv; }
}
__device__ __forceinline__ void gmlp_unit(const Ctx& C, const bf16* PROJ, bf16* MIXIN, const bf16* WSPM, const float* b_sp, const float* gln_g, const float* gln_b, int blk, int grp) {
    LAS unsigned char* lds = C.lds; constexpr int WOFF = 34816;
    const int lane = C.lane, w = C.wave, g = lane >> 4, li = lane & 15;
    __syncthreads();
#pragma unroll
    for (int i = 0; i < 4; ++i) { const int ch = C.tid + NTHREADS * i, row = ch >> 4, cc = ch & 15;
        *(LAS v4u*)(lds + WOFF + row * 272 + cc * 16) = *(const GAS v4u*)(WSPM + grp * 16384 + row * 128 + cc * 8); }
    f32x4 gg0, gg1, bb0, bb1;
    { const GAS f32x4* gp = (const GAS f32x4*)(gln_g + lane * 8); gg0 = gp[0]; gg1 = gp[1]; const GAS f32x4* bp = (const GAS f32x4*)(gln_b + lane * 8); bb0 = bp[0]; bb1 = bp[1]; }
    for (int rr = 0; rr < 16; ++rr) {
        const int row = 16 * w + rr;
        const v4u raw = *(const GAS v4u*)(PROJ + ((size_t)blk * 128 + row) * NIN + 512 + lane * 8);
        f32x4 v0 = {bf_lo(raw.x), bf_hi(raw.x), bf_lo(raw.y), bf_hi(raw.y)}, v1 = {bf_lo(raw.z), bf_hi(raw.z), bf_lo(raw.w), bf_hi(raw.w)};
        const float mean = wave_sum((v0[0] + v0[1]) + (v0[2] + v0[3]) + (v1[0] + v1[1]) + (v1[2] + v1[3])) * (1.f / 512.f);
        v0 = v0 - mean; v1 = v1 - mean;
        const float var = wave_sum((v0[0] * v0[0] + v0[1] * v0[1]) + (v0[2] * v0[2] + v0[3] * v0[3]) + (v1[0] * v1[0] + v1[1] * v1[1]) + (v1[2] * v1[2] + v1[3] * v1[3])) * (1.f / 512.f);
        const float rstd = 1.f / sqrtf(var + LN_EPS);
        if (g == grp) { const f32x4 y0 = v0 * rstd * gg0 + bb0, y1 = v1 * rstd * gg1 + bb1; *(LAS bf16x8*)(lds + row * 272 + li * 16) = pack8(y0, y1); }
    }
    __syncthreads();
    f32x4 acc[8];
#pragma unroll
    for (int mt = 0; mt < 8; ++mt) acc[mt] = (f32x4){0.f, 0.f, 0.f, 0.f};
    const int nks = (w < 4) ? 2 : 4;
    for (int ks = 0; ks < nks; ++ks) {
        const bf16x8 bw = *(const LAS bf16x8*)(lds + WOFF + (16 * w + li) * 272 + (32 * ks + 8 * g) * 2);
#pragma unroll
        for (int mt = 0; mt < 8; ++mt) {
            LAS unsigned char* p = lds + (32 * ks + 8 * g + (li >> 2)) * 272 + (16 * mt + 4 * (li & 3)) * 2;
            const s16x4 lo = tr4(p), hi = tr4(p + 4 * 272);
            acc[mt] = MFMA16(cat8(lo, hi), bw, acc[mt]);
        }
    }
    const int i = 16 * w + li; const size_t row = (size_t)blk * 128 + i; const float bias = b_sp[grp * 128 + i];
#pragma unroll
    for (int mt = 0; mt < 8; ++mt) { const int c0 = 128 * grp + 16 * mt + 4 * g;
        const u32x2v ur = *(const GAS u32x2v*)(PROJ + row * NIN + c0);
        const f32x4 sv = acc[mt] + bias;
        u32x2v wv; wv.x = pg8::cvt_pk_bf16(bf_lo(ur.x) * sv[0], bf_hi(ur.x) * sv[1]); wv.y = pg8::cvt_pk_bf16(bf_lo(ur.y) * sv[2], bf_hi(ur.y) * sv[3]);
        *(GAS u32x2v*)(MIXIN + row * DM + c0) = wv; }
}

__device__ __forceinline__ void xattn_unit(const Ctx& C, const bf16* XQ, const bf16* XKV, bf16* XO, int b, int xh, int qt8) {
    LAS unsigned char* lds = C.lds;
    const int lane = C.lane, w = C.wave, g = lane >> 4, li = lane & 15;
    const size_t tok = (size_t)b * SEQ + 128 * qt8 + 16 * w + li;
    bf16x8 qf[8];
#pragma unroll
    for (int ks = 0; ks < 8; ++ks) qf[ks] = *(const GAS bf16x8*)(XQ + tok * DM + 256 * xh + 32 * ks + 8 * g);
    __syncthreads();
    {   v4u t[16];
#pragma unroll
        for (int i = 0; i < 16; ++i) { const int ch = C.tid + NTHREADS * i, row = ch >> 5, cc = ch & 31; t[i] = *(const GAS v4u*)(XKV + ((size_t)b * MEMLEN + row) * 2048 + 256 * xh + cc * 8); }
#pragma unroll
        for (int i = 0; i < 16; ++i) { const int ch = C.tid + NTHREADS * i, row = ch >> 5, cc = ch & 31; *(LAS v4u*)(lds + row * 544 + cc * 16) = t[i]; } }
    __syncthreads();
    f32x4 s[16];
#pragma unroll
    for (int mt = 0; mt < 16; ++mt) { s[mt] = (f32x4){0.f, 0.f, 0.f, 0.f};
#pragma unroll
        for (int ks = 0; ks < 8; ++ks) { const bf16x8 a = *(const LAS bf16x8*)(lds + (16 * mt + li) * 544 + (32 * ks + 8 * g) * 2); s[mt] = MFMA16(a, qf[ks], s[mt]); } }
    float mx = -1e30f;
#pragma unroll
    for (int mt = 0; mt < 16; ++mt) mx = fmaxf(mx, fmaxf(fmaxf(s[mt][0], s[mt][1]), fmaxf(s[mt][2], s[mt][3])));
    mx = fmaxf(mx, __shfl_xor(mx, 16)); mx = fmaxf(mx, __shfl_xor(mx, 32));
    float rs = 0.f;
#pragma unroll
    for (int mt = 0; mt < 16; ++mt)
#pragma unroll
        for (int r = 0; r < 4; ++r) { s[mt][r] = __builtin_amdgcn_exp2f(s[mt][r] - mx); rs += s[mt][r]; }
    rs += __shfl_xor(rs, 16); rs += __shfl_xor(rs, 32);
    const float il = 1.f / rs;
    bf16x8 pf[8];
#pragma unroll
    for (int kk = 0; kk < 8; ++kk) pf[kk] = pack8(s[2 * kk], s[2 * kk + 1]);
    __syncthreads();
    {   v4u t[16];
#pragma unroll
        for (int i = 0; i < 16; ++i) { const int ch = C.tid + NTHREADS * i, row = ch >> 5, cc = ch & 31; t[i] = *(const GAS v4u*)(XKV + ((size_t)b * MEMLEN + row) * 2048 + 1024 + 256 * xh + cc * 8); }
#pragma unroll
        for (int i = 0; i < 16; ++i) { const int ch = C.tid + NTHREADS * i, row = ch >> 5, cc = ch & 31; *(LAS v4u*)(lds + row * 544 + cc * 16) = t[i]; } }
    __syncthreads();
#pragma unroll 4
    for (int dt = 0; dt < 16; ++dt) {
        f32x4 o = {0.f, 0.f, 0.f, 0.f};
#pragma unroll
        for (int kk = 0; kk < 8; ++kk) {
            LAS unsigned char* p = lds + (32 * kk + 4 * g + (li >> 2)) * 544 + (16 * dt + 4 * (li & 3)) * 2;
            const s16x4 lo = tr4(p), hi = tr4(p + 16 * 544);
            o = MFMA16(cat8(lo, hi), pf[kk], o);
        }
        o = o * il; u32x2v wv; wv.x = pg8::cvt_pk_bf16(o[0], o[1]); wv.y = pg8::cvt_pk_bf16(o[2], o[3]);
        *(GAS u32x2v*)(XO + tok * DM + 256 * xh + 16 * dt + 4 * g) = wv;
    }
}

__device__ __forceinline__ unsigned ord_key(float x) { const unsigned u = __float_as_uint(x); return u ^ ((unsigned)((int)u >> 31) | 0x80000000u); }
__device__ __forceinline__ float ord_val(unsigned k) { return __uint_as_float(k ^ ((k & 0x80000000u) ? 0x80000000u : 0xffffffffu)); }
#define CEX_DESC(a, b) do { const unsigned _h = (a) > (b) ? (a) : (b), _l = (a) > (b) ? (b) : (a); (a) = _h; (b) = _l; } while (0)
template <int N> __device__ __forceinline__ void bitonic_sort_desc(unsigned (&v)[N]) {
#pragma unroll
    for (int k = 2; k <= N; k <<= 1)
#pragma unroll
        for (int j = k >> 1; j > 0; j >>= 1)
#pragma unroll
            for (int i = 0; i < N; ++i) { const int p = i ^ j; if (p > i) { if ((i & k) == 0) CEX_DESC(v[i], v[p]); else CEX_DESC(v[p], v[i]); } }
}
__device__ __forceinline__ void bitonic_merge16_desc(unsigned (&v)[16]) {
#pragma unroll
    for (int j = 8; j > 0; j >>= 1)
#pragma unroll
        for (int i = 0; i < 16; ++i) { const int p = i ^ j; if (p > i) CEX_DESC(v[i], v[p]); }
}
__device__ __forceinline__ void merge_xor(unsigned (&L)[16], int d) {
    unsigned o[16];
#pragma unroll
    for (int i = 0; i < 16; ++i) o[i] = (unsigned)__shfl_xor((int)L[i], d);
#pragma unroll
    for (int i = 0; i < 16; ++i) L[i] = L[i] > o[15 - i] ? L[i] : o[15 - i];
    bitonic_merge16_desc(L);
}
__host__ __device__ constexpr int cand_code(int n) {
    int cnt = 0;
    for (int i = 0; i < 16; ++i) for (int j = 0; j < 16; ++j) if ((i + 1) * (j + 1) <= 16) { if (cnt == n) return (i << 4) | j; ++cnt; }
    return -1;
}
template <int CODE> __device__ __forceinline__ unsigned cand_mk(const float (&va)[16], const float (&vb)[16]) {
    if constexpr (CODE >= 0) { const float sm = va[(CODE >> 4) & 15] + vb[CODE & 15]; return (ord_key(sm) & ~255u) | (unsigned)CODE; } else return 0u;
}
template <int TT> __device__ __forceinline__ unsigned cand_key(const float (&va)[16], const float (&vb)[16], int g) {
    const unsigned k0 = cand_mk<cand_code(TT)>(va, vb), k1 = cand_mk<cand_code(16 + TT)>(va, vb), k2 = cand_mk<cand_code(32 + TT)>(va, vb), k3 = cand_mk<cand_code(48 + TT)>(va, vb);
    return g == 0 ? k0 : (g == 1 ? k1 : (g == 2 ? k2 : k3));
}
__device__ __forceinline__ void route_unit(const Ctx& C, const bf16* PQ, const bf16* SKB, unsigned short* RIDX, float* RGATE, int tile, int h, float* dbg) {
    LAS unsigned char* lds = C.lds;
    const int lane = C.lane, w = C.wave, g = lane >> 4, li = lane & 15;
    __syncthreads();
#pragma unroll
    for (int i = 0; i < 8; ++i) { const int ch = C.tid + NTHREADS * i, p = ch >> 11, row = (ch >> 4) & 127, cc = ch & 15;
        *(LAS v4u*)(lds + p * 34816 + row * 272 + cc * 16) = *(const GAS v4u*)(SKB + ((size_t)(2 * h + p) * 128 + row) * 128 + cc * 8); }
    __syncthreads();
    const size_t tok = (size_t)tile * 128 + 16 * w + li;
    unsigned La[16], Lb[16];
#pragma unroll
    for (int p = 0; p < 2; ++p) {
        bf16x8 qf[4];
#pragma unroll
        for (int ks = 0; ks < 4; ++ks) qf[ks] = *(const GAS bf16x8*)(PQ + tok * 2048 + 256 * h + 128 * p + 32 * ks + 8 * g);
        unsigned key[32];
#pragma unroll
        for (int mt = 0; mt < 8; ++mt) { f32x4 sc = {0.f, 0.f, 0.f, 0.f};
#pragma unroll
            for (int ks = 0; ks < 4; ++ks) { const bf16x8 a = *(const LAS bf16x8*)(lds + p * 34816 + (16 * mt + li) * 272 + (32 * ks + 8 * g) * 2); sc = MFMA16(a, qf[ks], sc); }
#pragma unroll
            for (int r = 0; r < 4; ++r) key[4 * mt + r] = (ord_key(sc[r]) & ~127u) | (unsigned)(16 * mt + 4 * g + r); }
        bitonic_sort_desc<32>(key);
        unsigned L[16];
#pragma unroll
        for (int i = 0; i < 16; ++i) L[i] = key[i];
        merge_xor(L, 16); merge_xor(L, 32);
#pragma unroll
        for (int i = 0; i < 16; ++i) { if (p == 0) La[i] = L[i]; else Lb[i] = L[i]; }
    }
#if DBG_STAT == 10
    if (g == 0) {
        float best = -1e30f; int bi = -1;
        for (int k = 0; k < 128; ++k) { float a = 0.f;
            for (int d = 0; d < 128; ++d) a += bf_lo((unsigned)PQ[tok * 2048 + 256 * h + d]) * bf_lo((unsigned)SKB[((size_t)(2 * h) * 128 + k) * 128 + d]);
            if (a > best) { best = a; bi = k; } }
        if (bi != (int)(La[0] & 127u)) atomicAdd(dbg, 1.f / (float)(T * 8));
    }
#endif
    float va[16], vb[16];
#pragma unroll
    for (int i = 0; i < 16; ++i) { va[i] = ord_val(La[i] & ~127u); vb[i] = ord_val(Lb[i] & ~127u); }
    unsigned F[16];
#define CANDT(t) F[t] = cand_key<t>(va, vb, g);
    CANDT(0) CANDT(1) CANDT(2) CANDT(3) CANDT(4) CANDT(5) CANDT(6) CANDT(7) CANDT(8) CANDT(9) CANDT(10) CANDT(11) CANDT(12) CANDT(13) CANDT(14) CANDT(15)
#undef CANDT
    bitonic_sort_desc<16>(F);
    merge_xor(F, 16); merge_xor(F, 32);
    unsigned da = La[0] & 127u, db = Lb[0] & 127u;
#pragma unroll
    for (int n = 1; n < 16; ++n) { da = li == n ? (La[n] & 127u) : da; db = li == n ? (Lb[n] & 127u) : db; }
    float gv[16], gs = 0.f; const float g0 = ord_val(F[0] & ~255u);
#pragma unroll
    for (int k = 0; k < 16; ++k) { gv[k] = __builtin_amdgcn_exp2f((ord_val(F[k] & ~255u) - g0) * LOG2E); gs += gv[k]; }
    const float ig = 1.f / gs;
#pragma unroll
    for (int k = 0; k < 16; ++k) {
        const int ci = (F[k] >> 4) & 15, cj = F[k] & 15;
        int i1 = 0, i2 = 0;
#pragma unroll
        for (int n = 0; n < 16; ++n) { i1 = ci == n ? (int)(La[n] & 127u) : i1; i2 = cj == n ? (int)(Lb[n] & 127u) : i2; }
        if (g == 0) { RIDX[tok * 128 + 16 * h + k] = (unsigned short)(i1 * 128 + i2); RGATE[tok * 128 + 16 * h + k] = gv[k] * ig; }
#if DBG_STAT == 12
        if (k == 0 && g == 0 && (i1 * 128 + i2) != (int)((La[0] & 127u) * 128u + (Lb[0] & 127u))) atomicAdd(dbg, 1.f / (float)(T * 8));
        if (k == 1 && g == 0) { const int e01 = (int)((La[0] & 127u) * 128u + (Lb[1] & 127u)), e10 = (int)((La[1] & 127u) * 128u + (Lb[0] & 127u)); if ((i1 * 128 + i2) != e01 && (i1 * 128 + i2) != e10) atomicAdd(dbg, 1.f / (float)(T * 8)); }
#endif
    }
}

__device__ __forceinline__ float dot2u(unsigned a, unsigned b, float acc) {
    return __builtin_amdgcn_fdot2_f32_bf16(__builtin_bit_cast(v2bf16, a), __builtin_bit_cast(v2bf16, b), acc, false);
}
__device__ __forceinline__ float dot8(v4u a, v4u b, float acc) {
    const unsigned a0 = a.x, a1 = a.y, a2 = a.z, a3 = a.w, b0 = b.x, b1 = b.y, b2 = b.z, b3 = b.w;
    acc = dot2u(a0, b0, acc); acc = dot2u(a1, b1, acc); acc = dot2u(a2, b2, acc); acc = dot2u(a3, b3, acc);
    return acc;
}
typedef float f32x2v __attribute__((ext_vector_type(2)));
__device__ __forceinline__ void unpack16(v4u w, float (&f)[16]) {
    const unsigned w0 = w.x, w1 = w.y, w2 = w.z, w3 = w.w;
    f32x2v t;
    t = __builtin_amdgcn_cvt_pk_f32_fp8((int)w0, false); f[0] = t.x; f[1] = t.y;   t = __builtin_amdgcn_cvt_pk_f32_fp8((int)w0, true); f[2] = t.x; f[3] = t.y;
    t = __builtin_amdgcn_cvt_pk_f32_fp8((int)w1, false); f[4] = t.x; f[5] = t.y;   t = __builtin_amdgcn_cvt_pk_f32_fp8((int)w1, true); f[6] = t.x; f[7] = t.y;
    t = __builtin_amdgcn_cvt_pk_f32_fp8((int)w2, false); f[8] = t.x; f[9] = t.y;   t = __builtin_amdgcn_cvt_pk_f32_fp8((int)w2, true); f[10] = t.x; f[11] = t.y;
    t = __builtin_amdgcn_cvt_pk_f32_fp8((int)w3, false); f[12] = t.x; f[13] = t.y; t = __builtin_amdgcn_cvt_pk_f32_fp8((int)w3, true); f[14] = t.x; f[15] = t.y;
}
__device__ __forceinline__ void unpack16v(v4u w, f32x2v (&f)[8]) {
    const unsigned w0 = w.x, w1 = w.y, w2 = w.z, w3 = w.w;
    f[0] = __builtin_amdgcn_cvt_pk_f32_fp8((int)w0, false); f[1] = __builtin_amdgcn_cvt_pk_f32_fp8((int)w0, true);
    f[2] = __builtin_amdgcn_cvt_pk_f32_fp8((int)w1, false); f[3] = __builtin_amdgcn_cvt_pk_f32_fp8((int)w1, true);
    f[4] = __builtin_amdgcn_cvt_pk_f32_fp8((int)w2, false); f[5] = __builtin_amdgcn_cvt_pk_f32_fp8((int)w2, true);
    f[6] = __builtin_amdgcn_cvt_pk_f32_fp8((int)w3, false); f[7] = __builtin_amdgcn_cvt_pk_f32_fp8((int)w3, true);
}
__device__ __forceinline__ void load_idx16(const unsigned short* p, unsigned (&ei)[16]) {
    const v4u ea = *(const GAS v4u*)p, eb = *(const GAS v4u*)(p + 8);
    const unsigned a0 = ea.x, a1 = ea.y, a2 = ea.z, a3 = ea.w, b0 = eb.x, b1 = eb.y, b2 = eb.z, b3 = eb.w;
    ei[0] = a0 & 0xffffu; ei[1] = a0 >> 16; ei[2] = a1 & 0xffffu; ei[3] = a1 >> 16; ei[4] = a2 & 0xffffu; ei[5] = a2 >> 16; ei[6] = a3 & 0xffffu; ei[7] = a3 >> 16;
    ei[8] = b0 & 0xffffu; ei[9] = b0 >> 16; ei[10] = b1 & 0xffffu; ei[11] = b1 >> 16; ei[12] = b2 & 0xffffu; ei[13] = b2 >> 16; ei[14] = b3 & 0xffffu; ei[15] = b3 >> 16;
}
__device__ __forceinline__ void peer_u_phase(const Ctx& C, const bf16* H2, const unsigned char* EU, const unsigned short* RIDX, float* ZP) {
    const int lane = C.lane, r = lane >> 3, j = lane & 7;
    const int s = (int)blockIdx.x & 7, m = (int)blockIdx.x >> 3, nmem = (C.G - s + 7) >> 3;
    const unsigned char* tab = EU + (size_t)s * ((size_t)NEXP * 128) + 16 * j;
    for (int tok = m * NWAVES + C.wave; tok < T; tok += nmem * NWAVES) {
        const v4u x0 = *(const GAS v4u*)(H2 + (size_t)tok * DM + 128 * s + 16 * j), x1 = *(const GAS v4u*)(H2 + (size_t)tok * DM + 128 * s + 16 * j + 8);
        f32x2v xf[8];
        { const unsigned a0 = x0.x, a1 = x0.y, a2 = x0.z, a3 = x0.w, b0 = x1.x, b1 = x1.y, b2 = x1.z, b3 = x1.w;
          xf[0] = (f32x2v){bf_lo(a0), bf_hi(a0)}; xf[1] = (f32x2v){bf_lo(a1), bf_hi(a1)}; xf[2] = (f32x2v){bf_lo(a2), bf_hi(a2)}; xf[3] = (f32x2v){bf_lo(a3), bf_hi(a3)};
          xf[4] = (f32x2v){bf_lo(b0), bf_hi(b0)}; xf[5] = (f32x2v){bf_lo(b1), bf_hi(b1)}; xf[6] = (f32x2v){bf_lo(b2), bf_hi(b2)}; xf[7] = (f32x2v){bf_lo(b3), bf_hi(b3)}; }
        unsigned ei[16]; load_idx16(RIDX + (size_t)tok * 128 + 16 * r, ei);
        v4u w[16];
#pragma unroll
        for (int i = 0; i < 16; ++i) w[i] = *(const GAS v4u*)(tab + (size_t)ei[i] * 128);
        float d[16];
#pragma unroll
        for (int i = 0; i < 16; ++i) { f32x2v f[8]; unpack16v(w[i], f); f32x2v acc = f[0] * xf[0];
#pragma unroll
            for (int q = 1; q < 8; ++q) acc += f[q] * xf[q];
            d[i] = acc.x + acc.y; }
        float r8[8], r4[4], r2[2];
        { const bool hi = (lane & 4) != 0;
#pragma unroll
          for (int i = 0; i < 8; ++i) { const float keep = hi ? d[i + 8] : d[i], send = hi ? d[i] : d[i + 8]; r8[i] = keep + __shfl_xor(send, 4); } }
        { const bool hi = (lane & 2) != 0;
#pragma unroll
          for (int i = 0; i < 4; ++i) { const float keep = hi ? r8[i + 4] : r8[i], send = hi ? r8[i] : r8[i + 4]; r4[i] = keep + __shfl_xor(send, 2); } }
        { const bool hi = (lane & 1) != 0;
#pragma unroll
          for (int i = 0; i < 2; ++i) { const float keep = hi ? r4[i + 2] : r4[i], send = hi ? r4[i] : r4[i + 2]; r2[i] = keep + __shfl_xor(send, 1); } }
        *(GAS f32x2v*)(ZP + ((size_t)s * T + tok) * 128 + 2 * lane) = (f32x2v){r2[0], r2[1]};
    }
}
__device__ __forceinline__ void peer_a_phase(const Ctx& C, const float* ZP, float* RGATE) {
    for (size_t i = ((size_t)C.vcu * NTHREADS + C.tid) * 4; i < (size_t)T * 128; i += (size_t)C.G * NTHREADS * 4) {
        f32x4 z = *(const GAS f32x4*)(ZP + i);
#pragma unroll
        for (int s = 1; s < 8; ++s) z += *(const GAS f32x4*)(ZP + (size_t)s * T * 128 + i);
        z = z * (1.f / EU_SCALE);
        const f32x4 g = *(const GAS f32x4*)(RGATE + i);
        const pg8::f32x2 a = pg8::gelu_pk((pg8::f32x2){z[0], z[1]}), b = pg8::gelu_pk((pg8::f32x2){z[2], z[3]});
        *(GAS f32x4*)(RGATE + i) = (f32x4){a.x, a.y, b.x, b.y} * g * (1.f / EV_SCALE);
    }
}
__device__ __forceinline__ void peer_v_phase(const Ctx& C, const unsigned char* EV, const unsigned short* RIDX, const float* AV, float* FF) {
    const int lane = C.lane, r = lane >> 3, j = lane & 7;
    const int s = (int)blockIdx.x & 7, m = (int)blockIdx.x >> 3, nmem = (C.G - s + 7) >> 3;
    const unsigned char* tab = EV + (size_t)s * ((size_t)NEXP * 128) + 16 * j;
    for (int tok = m * NWAVES + C.wave; tok < T; tok += nmem * NWAVES) {
        unsigned ei[16]; load_idx16(RIDX + (size_t)tok * 128 + 16 * r, ei);
        f32x4 av[4];
#pragma unroll
        for (int q = 0; q < 4; ++q) av[q] = *(const GAS f32x4*)(AV + (size_t)tok * 128 + 16 * r + 4 * q);
        v4u w[16];
#pragma unroll
        for (int i = 0; i < 16; ++i) w[i] = *(const GAS v4u*)(tab + (size_t)ei[i] * 128);
        f32x2v o[8];
#pragma unroll
        for (int q = 0; q < 8; ++q) o[q] = (f32x2v){0.f, 0.f};
#pragma unroll
        for (int i = 0; i < 16; ++i) { f32x2v f[8]; unpack16v(w[i], f); const float a = av[i >> 2][i & 3]; const f32x2v a2 = {a, a};
#pragma unroll
            for (int q = 0; q < 8; ++q) o[q] += a2 * f[q]; }
        f32x2v r4[4], r2[2], r1;
        { const bool hi = (lane & 32) != 0;
#pragma unroll
          for (int i = 0; i < 4; ++i) { const f32x2v keep = hi ? o[i + 4] : o[i], send = hi ? o[i] : o[i + 4]; r4[i].x = keep.x + __shfl_xor(send.x, 32); r4[i].y = keep.y + __shfl_xor(send.y, 32); } }
        { const bool hi = (lane & 16) != 0;
#pragma unroll
          for (int i = 0; i < 2; ++i) { const f32x2v keep = hi ? r4[i + 2] : r4[i], send = hi ? r4[i] : r4[i + 2]; r2[i].x = keep.x + __shfl_xor(send.x, 16); r2[i].y = keep.y + __shfl_xor(send.y, 16); } }
        { const bool hi = (lane & 8) != 0; const f32x2v keep = hi ? r2[1] : r2[0], send = hi ? r2[0] : r2[1]; r1.x = keep.x + __shfl_xor(send.x, 8); r1.y = keep.y + __shfl_xor(send.y, 8); }
        *(GAS f32x2v*)(FF + (size_t)tok * DM + 128 * s + 16 * j + 2 * r) = r1;
    }
}
__device__ __forceinline__ void ln3_phase(const Ctx& C, const bf16* H2, const float* g3, const float* b3, float* out) {
    const int lane = C.lane, gw = C.vcu * NWAVES + C.wave, NGW = C.G * NWAVES;
    for (int tok = gw; tok < T; tok += NGW) {
        GAS f32x4* op = (GAS f32x4*)(out + (size_t)tok * DM) + lane;
        f32x4 v[4]; float s = 0.f;
#pragma unroll
        for (int q = 0; q < 4; ++q) { const u32x2v hb = *((const GAS u32x2v*)(H2 + (size_t)tok * DM) + lane + 64 * q);
            const f32x4 h = {bf_lo(hb.x), bf_hi(hb.x), bf_lo(hb.y), bf_hi(hb.y)};
            v[q] = op[64 * q] + h * DN_ALPHA; s += (v[q][0] + v[q][1]) + (v[q][2] + v[q][3]); }
        const float mean = wave_sum(s) * (1.f / DM); float s2 = 0.f;
#pragma unroll
        for (int q = 0; q < 4; ++q) { v[q] = v[q] - mean; s2 += (v[q][0] * v[q][0] + v[q][1] * v[q][1]) + (v[q][2] * v[q][2] + v[q][3] * v[q][3]); }
        const float rstd = 1.f / sqrtf(wave_sum(s2) * (1.f / DM) + LN_EPS);
#pragma unroll
        for (int q = 0; q < 4; ++q) op[64 * q] = v[q] * rstd * *((const GAS f32x4*)g3 + lane + 64 * q) + *((const GAS f32x4*)b3 + lane + 64 * q);
    }
}

constexpr int NPHASES = 15;
struct Args { const float* in[25]; float* out; unsigned char* ws; int ph_lo, ph_hi, li, pad; };
__global__ void __launch_bounds__(NTHREADS, 2) fwd_kernel(Args args) {
    extern __shared__ __attribute__((aligned(16))) unsigned char lds_raw[];
    Ctx C;
    C.lds = (LAS unsigned char*)lds_raw;
    C.tid = threadIdx.x; C.lane = C.tid & 63; C.wave = __builtin_amdgcn_readfirstlane(C.tid >> 6);
    C.G = gridDim.x; { const int bx = blockIdx.x; C.vcu = (C.G % 8 == 0) ? (bx % 8) * (C.G / 8) + bx / 8 : bx; }
    volatile LAS unsigned* MISC = (volatile LAS unsigned*)(C.lds + LDSCTL_OFF);
    unsigned char* ws = args.ws;
    gu32* ctl = (gu32*)(ws + WS_CTL);
    for (int u = C.tid; u < (LDS_BYTES - LDSCTL_OFF) / 4; u += NTHREADS) ((LAS unsigned*)(C.lds + LDSCTL_OFF))[u] = 0u;
    __syncthreads();
    const int lo = args.ph_lo, hi = args.ph_hi;
    const bool multi = (hi - lo) > 1;
    XcdBarrier bar; bar.bar = (unsigned*)(ctl + CW_BAR) + args.li * XCD_BAR_WORDS; bar.x = 0; bar.st = nullptr;
    if (multi) bar = xcd_barrier_post((unsigned*)(ctl + CW_BAR) + args.li * XCD_BAR_WORDS, MISC + 8);
#define IN(k) (lo <= (k) && (k) < hi)
#define SEAM(k) do { if (IN(k) && IN((k) + 1)) xcd_barrier(bar); } while (0)

    const float* x = args.in[0]; const float* mem = args.in[1]; const float* ln_in_g = args.in[2]; const float* ln_in_b = args.in[3]; const float* w_in = args.in[4];
    const float* gate_ln_g = args.in[5]; const float* gate_ln_b = args.in[6]; const float* w_sp = args.in[7]; const float* b_sp = args.in[8]; const float* rel_bias = args.in[9];
    const float* w_out = args.in[10]; const float* ln1_g = args.in[11]; const float* ln1_b = args.in[12]; const float* w_xq = args.in[13]; const float* w_xk = args.in[14];
    const float* w_xv = args.in[15]; const float* w_xo = args.in[16]; const float* ln2_g = args.in[17]; const float* ln2_b = args.in[18]; const float* w_pq = args.in[19];
    const float* sub_keys = args.in[20]; const float* expert_u = args.in[21]; const float* expert_v = args.in[22]; const float* ln3_g = args.in[23]; const float* ln3_b = args.in[24];
    bf16* WIN = (bf16*)(ws + WS_WIN); bf16* WOUT = (bf16*)(ws + WS_WOUT); bf16* WXQ = (bf16*)(ws + WS_WXQ); bf16* WXKV = (bf16*)(ws + WS_WXKV); bf16* WXO = (bf16*)(ws + WS_WXO);
    bf16* WPQ = (bf16*)(ws + WS_WPQ); bf16* SKB = (bf16*)(ws + WS_SKB); bf16* WSPM = (bf16*)(ws + WS_WSPM); unsigned char* EU = ws + WS_EU; unsigned char* EV = ws + WS_EV;
    bf16* PROJ = (bf16*)(ws + WS_PROJ); bf16* XQ = (bf16*)(ws + WS_XQ); bf16* XO = (bf16*)(ws + WS_XO); bf16* PQ = (bf16*)(ws + WS_PQ);
    bf16* H0 = (bf16*)(ws + WS_B); bf16* H2 = (bf16*)(ws + WS_B); bf16* MIXIN = (bf16*)(ws + WS_C); bf16* H1 = (bf16*)(ws + WS_C);
    bf16* MEMB = (bf16*)(ws + WS_MEMB); bf16* XKV = (bf16*)(ws + WS_XKV); unsigned short* RIDX = (unsigned short*)(ws + WS_RIDX); float* RGATE = (float*)(ws + WS_RGATE);
    float* Z = args.out;

    for (int rep_ = 0; rep_ < (0 == DBG_REPEAT ? 2 : 1); ++rep_) if (IN(0)) {
        P0Args a{x, mem, ln_in_g, ln_in_b, w_in, w_sp, w_out, w_xq, w_xk, w_xv, w_xo, w_pq, sub_keys, expert_u, expert_v, WIN, WOUT, WXQ, WXKV, WXO, WPQ, SKB, WSPM, EU, EV, H0, MEMB};
        p0_prologue(C, a);
    }
    SEAM(0);
    for (int rep_ = 0; rep_ < (1 == DBG_REPEAT ? 2 : 1); ++rep_) if (IN(1)) {
        pg8::Gemm2 g{H0, WIN, MEMB, WXKV, DM}; pg8::Order2 S; S.init(T, NIN, TMEM, 2048, C.G, (int)blockIdx.x);
        pg8::EpiProj E{PROJ, NIN, XKV, 2048, QB_SCALE, 1024, 1536};
        pg8::gemm_phase<pg8::EpiProj, pg8::Order2, true, true>(C.lds, g, S, E);
    }
    SEAM(1);
    for (int rep_ = 0; rep_ < (2 == DBG_REPEAT ? 2 : 1); ++rep_) if (IN(2)) {
        for (int v = C.vcu; v < 1536; v += C.G) {
            if (v < 1024) chunk_attn_unit(C, PROJ, MIXIN, rel_bias, v >> 7, (v >> 4) & 7, v & 15);
            else { const int u = v - 1024; gmlp_unit(C, PROJ, MIXIN, WSPM, b_sp, gate_ln_g, gate_ln_b, u >> 2, u & 3); }
        }
    }
    SEAM(2);
    for (int rep_ = 0; rep_ < (3 == DBG_REPEAT ? 2 : 1); ++rep_) if (IN(3)) {
        pg8::Gemm2 g{MIXIN, WOUT, MIXIN, WOUT, DM}; pg8::Order2 S; S.init(T, DM, 0, 256, C.G, (int)blockIdx.x);
        pg8::EpiZ E{H0, Z, DM, DN_ALPHA, (DBG_MASK & 1) ? 0.f : 1.f};
        pg8::gemm_phase<pg8::EpiZ, pg8::Order2, true, true>(C.lds, g, S, E);
    }
    SEAM(3);
    for (int rep_ = 0; rep_ < (4 == DBG_REPEAT ? 2 : 1); ++rep_) if (IN(4)) ln_pass(C, Z, ln1_g, ln1_b, H1);
    SEAM(4);
    for (int rep_ = 0; rep_ < (5 == DBG_REPEAT ? 2 : 1); ++rep_) if (IN(5)) {
        pg8::Gemm2 g{H1, WXQ, H1, WXQ, DM}; pg8::Order2 S; S.init(T, DM, 0, 256, C.G, (int)blockIdx.x);
        pg8::EpiProj E{XQ, DM, XQ, DM, XQ_SCALE, 0, 1 << 30};
        pg8::gemm_phase<pg8::EpiProj, pg8::Order2, true, true>(C.lds, g, S, E);
    }
    SEAM(5);
    for (int rep_ = 0; rep_ < (6 == DBG_REPEAT ? 2 : 1); ++rep_) if (IN(6)) {
        for (int v = C.vcu; v < 512; v += C.G) xattn_unit(C, XQ, XKV, XO, v >> 6, (v >> 4) & 3, v & 15);
    }
    SEAM(6);
    for (int rep_ = 0; rep_ < (7 == DBG_REPEAT ? 2 : 1); ++rep_) if (IN(7)) {
        pg8::Gemm2 g{XO, WXO, XO, WXO, DM}; pg8::Order2 S; S.init(T, DM, 0, 256, C.G, (int)blockIdx.x);
        pg8::EpiZ E{H1, Z, DM, DN_ALPHA, (DBG_MASK & 2) ? 0.f : 1.f};
        pg8::gemm_phase<pg8::EpiZ, pg8::Order2, true, true>(C.lds, g, S, E);
    }
    SEAM(7);
    for (int rep_ = 0; rep_ < (8 == DBG_REPEAT ? 2 : 1); ++rep_) if (IN(8)) ln_pass(C, Z, ln2_g, ln2_b, H2);
    SEAM(8);
    for (int rep_ = 0; rep_ < (9 == DBG_REPEAT ? 2 : 1); ++rep_) if (IN(9)) {
        pg8::Gemm2 g{H2, WPQ, H2, WPQ, DM}; pg8::Order2 S; S.init(T, 2048, 0, 256, C.G, (int)blockIdx.x);
        pg8::EpiProj E{PQ, 2048, PQ, 2048, 1.f, 0, 0};
        pg8::gemm_phase<pg8::EpiProj, pg8::Order2, true, true>(C.lds, g, S, E);
    }
    SEAM(9);
    for (int rep_ = 0; rep_ < (10 == DBG_REPEAT ? 2 : 1); ++rep_) if (IN(10)) {
        for (int v = C.vcu; v < 1024; v += C.G) route_unit(C, PQ, SKB, RIDX, RGATE, v >> 3, v & 7, (float*)(ctl + 64));
    }
    SEAM(10);
    float* ZP = (float*)(ws + WS_A);
    for (int rep_ = 0; rep_ < (11 == DBG_REPEAT ? 2 : 1); ++rep_) if (IN(11)) peer_u_phase(C, H2, EU, RIDX, ZP);
    SEAM(11);
    for (int rep_ = 0; rep_ < (12 == DBG_REPEAT ? 2 : 1); ++rep_) if (IN(12)) { if (rep_ == 0) peer_a_phase(C, ZP, RGATE); }
    SEAM(12);
    for (int rep_ = 0; rep_ < (13 == DBG_REPEAT ? 2 : 1); ++rep_) if (IN(13)) peer_v_phase(C, EV, RIDX, RGATE, args.out);
    SEAM(13);
    for (int rep_ = 0; rep_ < (14 == DBG_REPEAT ? 2 : 1); ++rep_) if (IN(14)) { if (rep_ == 0) ln3_phase(C, H2, ln3_g, ln3_b, args.out); }
#undef IN
#undef SEAM
}

extern "C" void kernel_launch(void* const* d_in, const int* in_sizes, int n_in, void* d_out, int out_size, void* d_ws, size_t ws_size, hipStream_t stream) {
    static int grid = 0;
    if (grid == 0) {
        if (n_in != 25 || in_sizes[0] != T * DM || out_size != T * DM || ws_size < WS_END) {
            fprintf(stderr, "kernel_launch: unexpected problem (n_in %d, in0 %d, out %d, ws %zu); nothing launched\n", n_in, n_in > 0 ? in_sizes[0] : -1, out_size, ws_size); grid = -1; return; }
        int dev = 0, cus = 0, per_cu = 0;
        if (hipGetDevice(&dev) != hipSuccess || hipDeviceGetAttribute(&cus, hipDeviceAttributeMultiprocessorCount, dev) != hipSuccess) { grid = -1; return; }
        if (hipFuncSetAttribute((const void*)fwd_kernel, hipFuncAttributeMaxDynamicSharedMemorySize, LDS_BYTES) != hipSuccess) { fprintf(stderr, "kernel_launch: hipFuncSetAttribute failed\n"); grid = -1; return; }
        if (hipOccupancyMaxActiveBlocksPerMultiprocessor(&per_cu, (const void*)fwd_kernel, NTHREADS, LDS_BYTES) != hipSuccess || per_cu < 1)
            fprintf(stderr, "kernel_launch: note: occupancy query reports %d workgroups per CU\n", per_cu);
        (void)hipGetLastError();
        grid = cus;
    }
    if (grid < 0) return;
    if (hipMemsetAsync((char*)d_ws + WS_CTL, 0, CTL_ZERO_BYTES, stream) != hipSuccess) { fprintf(stderr, "kernel_launch: memset failed\n"); return; }
    Args a{};
    for (int i = 0; i < 25; ++i) a.in[i] = (const float*)d_in[i];
    a.out = (float*)d_out; a.ws = (unsigned char*)d_ws;
    constexpr int NL = MK_N_LAUNCHES;
    static_assert(NL == 1 || NL == NPHASES, "MK_N_LAUNCHES: 1 (one launch) or NPHASES (one launch per phase)");
    for (int li = 0; li < (NL == 1 ? 1 : NPHASES); ++li) {
        a.ph_lo = (NL == 1) ? 0 : li; a.ph_hi = (NL == 1) ? NPHASES : li + 1; a.li = 0;
        hipLaunchKernelGGL(fwd_kernel, dim3(grid), dim3(NTHREADS), LDS_BYTES, stream, a);
        const hipError_t le = hipPeekAtLastError();
        if (le != hipSuccess) { fprintf(stderr, "kernel_launch: launch %d failed: %s\n", li, hipGetErrorName(le)); break; }
    }
}
```
